# Optimizing an MI355X kernel written in HIP

```python
import math
import jax, jax.numpy as jnp
from jax import lax
import numpy as np


D_MODEL = 1024
BATCH = 4
SEQ = 4096
DEPTH = 1

GRID_W = 64
CTX_LEN = 256
D_MIX = D_MODEL
D_FOURIER = D_MIX // 4
D_DIFF = D_MIX - D_FOURIER
DIFF_HEAD_DIM = 64
N_DIFF_HEADS = D_DIFF // (2 * DIFF_HEAD_DIM)
N_FOURIER_GROUPS = 4
FOURIER_GROUP_DIM = D_FOURIER // N_FOURIER_GROUPS
D_IN_PROJ = 3 * D_DIFF + D_FOURIER
D_FF = 2816
N_MOD = 9
ROPE_BASE = 10000.0
ROPE_PAIRS = DIFF_HEAD_DIM // 4
Q_BLOCK = 128
RMS_EPS = 1e-6
ATTN_SCALE = DIFF_HEAD_DIM ** -0.5

kernel_name = 'hymba_diff_fnet_macaron_dit_block'


def _rmsnorm(x, g):
    x32 = x.astype(jnp.float32)
    y = x32 * lax.rsqrt(jnp.mean(x32 * x32, axis=-1, keepdims=True) + RMS_EPS)
    return y.astype(x.dtype) * g


def _modulate(h, shift, scale):
    return h * (1 + scale[:, None, :]) + shift[:, None, :]


def _half_ffn(s, shift, scale, gate, g, w_gate, w_up, w_down):
    h = _modulate(_rmsnorm(s, g), shift, scale)
    return s + 0.5 * gate[:, None, :] * ((jax.nn.silu(h @ w_gate) * (h @ w_up)) @ w_down)


def _rope_tables(n_tokens):
    rows = n_tokens // GRID_W
    row = jnp.repeat(jnp.arange(rows, dtype=jnp.float32), GRID_W)
    col = jnp.tile(jnp.arange(GRID_W, dtype=jnp.float32), rows)
    inv_freq = ROPE_BASE ** (-jnp.arange(ROPE_PAIRS, dtype=jnp.float32) / ROPE_PAIRS)
    ang = jnp.stack([row[:, None] * inv_freq, col[:, None] * inv_freq], axis=1)
    return jnp.cos(ang), jnp.sin(ang)


def _apply_rope(x, cos, sin):
    xs = x.astype(jnp.float32).reshape(x.shape[:-1] + (2, 2, ROPE_PAIRS))
    x1, x2 = xs[..., 0, :], xs[..., 1, :]
    out = jnp.stack([x1 * cos - x2 * sin, x2 * cos + x1 * sin], axis=-2)
    return out.reshape(x.shape).astype(x.dtype)


def _split_proj(p):
    b, n, _ = p.shape
    q = p[..., :D_DIFF].reshape(b, n, N_DIFF_HEADS, 2, DIFF_HEAD_DIM).transpose(0, 2, 3, 1, 4)
    k = p[..., D_DIFF:2 * D_DIFF].reshape(b, n, N_DIFF_HEADS, 2, DIFF_HEAD_DIM).transpose(0, 2, 3, 1, 4)
    v = p[..., 2 * D_DIFF:3 * D_DIFF].reshape(b, n, N_DIFF_HEADS, 2 * DIFF_HEAD_DIM).transpose(0, 2, 1, 3)
    f = p[..., 3 * D_DIFF:]
    return q, k, v, f


def _lambda(lq1, lk1, lq2, lk2, lambda_init):
    e1 = jnp.exp(jnp.sum(lq1.astype(jnp.float32) * lk1.astype(jnp.float32)))
    e2 = jnp.exp(jnp.sum(lq2.astype(jnp.float32) * lk2.astype(jnp.float32)))
    return e1 - e2 + lambda_init


def _diff_maps_apply(q, keys, vals, lam):
    s = jnp.einsum('bhcqd,bhckd->bhcqk', q, keys).astype(jnp.float32) * ATTN_SCALE
    p = jax.nn.softmax(s, axis=-1)
    a = p[:, :, 0] - lam * p[:, :, 1]
    return jnp.einsum('bhqk,bhkv->bhqv', a.astype(vals.dtype), vals)


def _diff_attn_latent(q, k, v, k_ctx, v_ctx, lam):
    b, h, _, n, dh = q.shape
    keys = jnp.concatenate([k, k_ctx], axis=3)
    vals = jnp.concatenate([v, v_ctx], axis=2)
    qb = jnp.moveaxis(q.reshape(b, h, 2, n // Q_BLOCK, Q_BLOCK, dh), 3, 0)
    out = lax.map(lambda qi: _diff_maps_apply(qi, keys, vals, lam), qb)
    return jnp.moveaxis(out, 0, 2).reshape(b, h, n, 2 * dh)


def _diff_heads_out(o, subln_g, lambda_init):
    b, h, n, dv = o.shape
    o = _rmsnorm(o, subln_g) * (1.0 - lambda_init)
    return o.transpose(0, 2, 1, 3).reshape(b, n, h * dv)


def _fourier_mix(f, w_fourier):
    b, n, _ = f.shape
    g = f.astype(jnp.float32).reshape(b, n, N_FOURIER_GROUPS, FOURIER_GROUP_DIM)
    z = jnp.fft.fft2(g, axes=(1, 3), norm='ortho').real
    return z.reshape(b, n, D_FOURIER).astype(f.dtype) @ w_fourier


def setup_inputs(seed: int = 0) -> dict:
    key = jax.random.key(seed)
    ks = jax.random.split(key, 24)
    f32 = jnp.float32

    def nrm(k, shape, fan_in, gain=1.0):
        return jax.random.normal(k, shape, f32) * (gain * fan_in ** -0.5)

    def gain(k, shape):
        return 1.0 + 0.05 * jax.random.normal(k, shape, f32)

    return {
        'x': jax.random.normal(ks[0], (BATCH, SEQ, D_MODEL), f32),
        'c': jax.random.normal(ks[1], (BATCH, D_MODEL), f32),
        'ctx': jax.random.normal(ks[2], (BATCH, CTX_LEN, D_MODEL), f32),
        'c_ctx': jax.random.normal(ks[3], (D_MODEL,), f32),
        'w_ada': nrm(ks[4], (DEPTH, D_MODEL, N_MOD * D_MODEL), D_MODEL, 0.5),
        'b_ada': 0.01 * jax.random.normal(ks[5], (DEPTH, N_MOD * D_MODEL), f32),
        'norm1_g': gain(ks[6], (DEPTH, D_MODEL)),
        'ffn1_w_gate': nrm(ks[7], (DEPTH, D_MODEL, D_FF), D_MODEL),
        'ffn1_w_up': nrm(ks[8], (DEPTH, D_MODEL, D_FF), D_MODEL),
        'ffn1_w_down': nrm(ks[9], (DEPTH, D_FF, D_MODEL), D_FF),
        'norm_mix_g': gain(ks[10], (DEPTH, D_MODEL)),
        'w_in': nrm(ks[11], (DEPTH, D_MODEL, D_IN_PROJ), D_MODEL),
        'lambda_q1': 0.1 * jax.random.normal(ks[12], (DEPTH, DIFF_HEAD_DIM), f32),
        'lambda_k1': 0.1 * jax.random.normal(ks[13], (DEPTH, DIFF_HEAD_DIM), f32),
        'lambda_q2': 0.1 * jax.random.normal(ks[14], (DEPTH, DIFF_HEAD_DIM), f32),
        'lambda_k2': 0.1 * jax.random.normal(ks[15], (DEPTH, DIFF_HEAD_DIM), f32),
        'subln_g': gain(ks[16], (DEPTH, 2 * DIFF_HEAD_DIM)),
        'w_fourier': nrm(ks[17], (DEPTH, D_FOURIER, D_FOURIER), D_FOURIER),
        'w_out': nrm(ks[18], (DEPTH, D_MIX, D_MODEL), D_MIX),
        'norm2_g': gain(ks[19], (DEPTH, D_MODEL)),
        'ffn2_w_gate': nrm(ks[20], (DEPTH, D_MODEL, D_FF), D_MODEL),
        'ffn2_w_up': nrm(ks[21], (DEPTH, D_MODEL, D_FF), D_MODEL),
        'ffn2_w_down': nrm(ks[22], (DEPTH, D_FF, D_MODEL), D_FF),
        'final_norm_g': gain(ks[23], (D_MODEL,)),
    }


def reference(x, c, ctx, c_ctx, w_ada, b_ada, norm1_g, ffn1_w_gate, ffn1_w_up, ffn1_w_down,
              norm_mix_g, w_in, lambda_q1, lambda_k1, lambda_q2, lambda_k2, subln_g, w_fourier,
              w_out, norm2_g, ffn2_w_gate, ffn2_w_up, ffn2_w_down, final_norm_g):
    cos, sin = _rope_tables(x.shape[1])
    h_ctx = ctx
    silu_c = jax.nn.silu(c)
    silu_cc = jax.nn.silu(c_ctx)[None, :]
    for l in range(DEPTH):
        lambda_init = 0.8 - 0.6 * math.exp(-0.3 * l)
        update_ctx = l < DEPTH - 1
        mod_x = jnp.split(silu_c @ w_ada[l] + b_ada[l], N_MOD, axis=-1)
        mod_c = jnp.split(silu_cc @ w_ada[l] + b_ada[l], N_MOD, axis=-1)

        x = _half_ffn(x, mod_x[0], mod_x[1], mod_x[2], norm1_g[l], ffn1_w_gate[l], ffn1_w_up[l], ffn1_w_down[l])
        h_ctx = _half_ffn(h_ctx, mod_c[0], mod_c[1], mod_c[2], norm1_g[l], ffn1_w_gate[l], ffn1_w_up[l], ffn1_w_down[l])

        p_x = _modulate(_rmsnorm(x, norm_mix_g[l]), mod_x[3], mod_x[4]) @ w_in[l]
        p_c = _modulate(_rmsnorm(h_ctx, norm_mix_g[l]), mod_c[3], mod_c[4]) @ w_in[l]
        q, k, v, f = _split_proj(p_x)
        qc, kc, vc, fc = _split_proj(p_c)
        q = _apply_rope(q, cos, sin)
        k = _apply_rope(k, cos, sin)
        lam = _lambda(lambda_q1[l], lambda_k1[l], lambda_q2[l], lambda_k2[l], lambda_init)

        att = _diff_heads_out(_diff_attn_latent(q, k, v, kc, vc, lam), subln_g[l], lambda_init)
        mix = jnp.concatenate([att, _fourier_mix(f, w_fourier[l])], axis=-1) @ w_out[l]
        x = x + mod_x[5][:, None, :] * mix

        if update_ctx:
            att_c = _diff_heads_out(_diff_maps_apply(qc, kc, vc, lam), subln_g[l], lambda_init)
            mix_c = jnp.concatenate([att_c, _fourier_mix(fc, w_fourier[l])], axis=-1) @ w_out[l]
            h_ctx = h_ctx + mod_c[5][:, None, :] * mix_c
            h_ctx = _half_ffn(h_ctx, mod_c[6], mod_c[7], mod_c[8], norm2_g[l], ffn2_w_gate[l], ffn2_w_up[l], ffn2_w_down[l])

        x = _half_ffn(x, mod_x[6], mod_x[7], mod_x[8], norm2_g[l], ffn2_w_gate[l], ffn2_w_up[l], ffn2_w_down[l])
    return _rmsnorm(x, final_norm_g)
```

```cpp
#include <hip/hip_runtime.h>
#include <hip/hip_cooperative_groups.h>
#include <cstdio>
#include <cstdint>
namespace cg = cooperative_groups;

#ifndef MK_N_LAUNCHES
#define MK_N_LAUNCHES 12
#endif

#define LAS __attribute__((address_space(3)))
typedef unsigned short bf16_t;
typedef short bf16x8 __attribute__((ext_vector_type(8)));
typedef float f32x4 __attribute__((ext_vector_type(4)));
typedef float f32x2 __attribute__((ext_vector_type(2)));
typedef float f32x16 __attribute__((ext_vector_type(16)));
typedef unsigned u32x4 __attribute__((ext_vector_type(4)));
typedef unsigned u32x2 __attribute__((ext_vector_type(2)));

constexpr int DM = 1024, NB = 4, SEQ = 4096, CTXL = 256, MLAT = NB * SEQ, MCTX = NB * CTXL, MALL = MLAT + MCTX;
constexpr int DFF = 2816, MODLD = 9216, DQK = 768;
constexpr int NPH = 12;
constexpr float RMS_EPS = 1e-6f;
constexpr float QSCALE = 0.125f * 1.4426950408889634f;
constexpr float LAMBDA_INIT = 0.2f;

constexpr size_t MiB = 1u << 20;
constexpr size_t WS_SCAL = 0, WS_MOD = 4096, WS_ROPE = 256 * 1024;
constexpr size_t WS_WGU1 = 1 * MiB, WS_WD1 = 12 * MiB, WS_WGU2 = 18 * MiB, WS_WD2 = 29 * MiB, WS_WIN = 35 * MiB, WS_WF = 40 * MiB, WS_WO = 41 * MiB;
constexpr size_t WS_DFTM = 44 * MiB, WS_XN = 108 * MiB, WS_AO = WS_XN, WS_X1C = 142 * MiB, WS_H = 146 * MiB;
constexpr size_t WS_Q = 146 * MiB, WS_K = 170 * MiB, WS_VT = 196 * MiB, WS_DFTB = 222 * MiB, WS_END = 240 * MiB;

constexpr int LDS_BYTES = 132096;

__device__ __forceinline__ unsigned cvt_pk_bf16(float lo, float hi) { unsigned r; asm volatile("v_cvt_pk_bf16_f32 %0, %1, %2" : "=v"(r) : "v"(lo), "v"(hi)); return r; }
__device__ __forceinline__ float wave_sum(float v) {
#pragma unroll
    for (int o = 1; o < 64; o <<= 1) v += __shfl_xor(v, o);
    return v;
}
__device__ __forceinline__ float silu_f(float g) { return g * __builtin_amdgcn_rcpf(1.0f + __builtin_amdgcn_exp2f(-1.4426950408889634f * g)); }

namespace pg8 {
constexpr int BM = 256, BK = 64, HALF = 128, HTB = HALF * BK * 2, STAGE_BYTES = 8 * HTB, WGM = 8;
__host__ __device__ __forceinline__ int lds_byte(int r, int c) { const int st = (r >> 4) * 2 + (c >> 5), rr = r & 15, cc = c & 31, ob = rr * 64 + cc * 2; return st * 1024 + (ob ^ (((ob >> 9) & 1) << 5)); }
__host__ __device__ __forceinline__ void stage_rc(int b, int& R, int& C) { const int st = b / 1024, sb = b % 1024, swz = sb ^ (((sb >> 9) & 1) << 5); R = (st >> 1) * 16 + swz / 64; C = (st & 1) * 32 + (swz % 64) / 2; }
__host__ __device__ __forceinline__ int perm32(int rho) { const int n = rho >> 4, i = rho & 15; return 8 * (i >> 2) + 4 * n + (i & 3); }

struct Unit { int pm, pn, kind; const char* a; const char* b; };
struct Gemm { int K, lda, ldb; };

struct Seg { int nM, nN, kind; const char* a; const char* b; size_t ta, tb; };
__device__ __forceinline__ bool seg_take(const Seg& s, int& w, Unit& u) {
    const int n = s.nM * s.nN;
    if (w >= n) { w -= n; return false; }
    const int nig = WGM * s.nN, gid = w / nig, fm = gid * WGM, gsz = (s.nM - fm) < WGM ? (s.nM - fm) : WGM;
    u.pm = fm + ((w % nig) % gsz); u.pn = (w % nig) / gsz; u.kind = s.kind;
    u.a = s.a + (size_t)u.pm * s.ta; u.b = s.b + (size_t)u.pn * s.tb; return true;
}
struct Order {
    Seg s0, s1, s2, s3; int nseg, G, c, total;
    __device__ __forceinline__ bool next(int i, Unit& u) const {
        const long L = (long)i * G + c; if (L >= total) return false;
        int w = (int)L; { const int q = total / 8, r = total % 8, xcd = w % 8, off = w / 8; w = (xcd < r ? xcd * (q + 1) : r * (q + 1) + (xcd - r) * q) + off; }
        if (seg_take(s0, w, u)) return true;
        if (nseg > 1 && seg_take(s1, w, u)) return true;
        if (nseg > 2 && seg_take(s2, w, u)) return true;
        if (nseg > 3 && seg_take(s3, w, u)) return true;
        return false;
    }
};

template <class Epi>
__device__ __forceinline__ void gemm_phase(LAS unsigned char* lds, const Gemm g, const Order& S, const Epi& E) {
    constexpr bool ALIGN_EPI = true;
    const int tid = threadIdx.x, wid = __builtin_amdgcn_readfirstlane(tid >> 6), lane = tid & 63, wr = wid >> 2, wc = wid & 3, fr = lane & 15, fq = lane >> 4;
    const int K = g.K, nt = K / BK;
    unsigned voffA[2], voffB[2];
#pragma unroll
    for (int i = 0; i < 2; ++i) { int R, C; stage_rc(tid * 16 + i * 8192, R, C); const int Rb = Epi::PERM ? ((R & ~31) + perm32(R & 31)) : R;
        voffA[i] = (unsigned)(R * g.lda + C) * 2u; voffB[i] = (unsigned)(Rb * g.ldb + C) * 2u; }
    const size_t kstep = (size_t)(BK * 2);
    const size_t hstepA = (size_t)HALF * g.lda * 2, hstepB = (size_t)HALF * g.ldb * 2;
    const unsigned ldsw = (unsigned)wid * 1024u;
    const int aoff = lds_byte(wr * 64 + fr, fq * 8), boff = lds_byte(wc * 32 + fr, fq * 8);
#define PG8_SA(b, h) (((b) * 2 + (h)) * HTB)
#define PG8_SB(b, h) ((4 + (b) * 2 + (h)) * HTB)
#define PG8_STAGE(bufoff, gbase, voff) do { _Pragma("unroll") for (int _i = 0; _i < 2; ++_i) \
        __builtin_amdgcn_global_load_lds((const unsigned*)((const char*)(gbase) + (voff)[_i]), (LAS unsigned*)(lds + (bufoff) + ldsw + _i * 8192), 16, 0, 0); } while (0)
#define PG8_LDA(dst, b, h) do { _Pragma("unroll") for (int m = 0; m < 4; ++m) _Pragma("unroll") for (int k = 0; k < 2; ++k) dst[m][k] = *(const LAS bf16x8*)(lds + PG8_SA(b, h) + aoff + m * 2048 + k * 1024); } while (0)
#define PG8_LDB(dst, b, h) do { _Pragma("unroll") for (int n = 0; n < 2; ++n) _Pragma("unroll") for (int k = 0; k < 2; ++k) dst[n][k] = *(const LAS bf16x8*)(lds + PG8_SB(b, h) + boff + n * 2048 + k * 1024); } while (0)
#define PG8_MMA(ai, bj, At, Bt) do { __builtin_amdgcn_s_setprio(1); _Pragma("unroll") for (int m = 0; m < 4; ++m) _Pragma("unroll") for (int n = 0; n < 2; ++n) _Pragma("unroll") for (int k = 0; k < 2; ++k) \
        acc[ai][bj][m][n] = __builtin_amdgcn_mfma_f32_16x16x32_bf16(Bt[n][k], At[m][k], acc[ai][bj][m][n], 0, 0, 0); __builtin_amdgcn_s_setprio(0); } while (0)
#define PG8_WAIT_V(n) asm volatile("s_waitcnt vmcnt(" #n ")" ::: "memory")
#define PG8_WAIT_L(n) asm volatile("s_waitcnt lgkmcnt(" #n ")" ::: "memory")
#define PG8_BAR __builtin_amdgcn_s_barrier()
#define PG8_SCHED __builtin_amdgcn_sched_barrier(0)
    Unit cur, nxt; int ui = 0;
    if (!S.next(0, cur)) return;
    f32x4 acc[2][2][4][2];
#pragma unroll
    for (int a = 0; a < 2; ++a)
#pragma unroll
        for (int b = 0; b < 2; ++b)
#pragma unroll
            for (int m = 0; m < 4; ++m)
#pragma unroll
                for (int n = 0; n < 2; ++n) acc[a][b][m][n] = (f32x4){0.f, 0.f, 0.f, 0.f};
    bf16x8 At[4][2], B0[2][2], B1[2][2];
    const char* cA = cur.a; const char* cB = cur.b;
    PG8_STAGE(PG8_SB(0, 0), cB, voffB); PG8_STAGE(PG8_SB(0, 1), cB + hstepB, voffB); PG8_STAGE(PG8_SA(0, 0), cA, voffA); PG8_STAGE(PG8_SA(0, 1), cA + hstepA, voffA);
    if (wr == 1) PG8_BAR;
    PG8_WAIT_V(2); PG8_BAR;
    PG8_STAGE(PG8_SB(1, 0), cB + kstep, voffB); PG8_STAGE(PG8_SA(1, 0), cA + kstep, voffA); PG8_STAGE(PG8_SB(1, 1), cB + hstepB + kstep, voffB);
    PG8_WAIT_V(6); PG8_BAR;
    for (;;) {
        const bool has_next = S.next(ui + 1, nxt);
        const char* nA = has_next ? nxt.a : cA; const char* nB = has_next ? nxt.b : cB;
        for (int t = 0; t < nt; t += 2) {
            const bool last = (t == nt - 2);
            const char* a1 = cA + (size_t)(t + 1) * kstep;
            const char* a2 = last ? nA : cA + (size_t)(t + 2) * kstep; const char* b2 = last ? nB : cB + (size_t)(t + 2) * kstep;
            const char* a3 = a2 + kstep; const char* b3 = b2 + kstep;
            PG8_LDB(B0, 0, 0); PG8_LDB(B1, 0, 1); PG8_SCHED; PG8_LDA(At, 0, 0); PG8_STAGE(PG8_SA(1, 1), a1 + hstepA, voffA);
            PG8_WAIT_V(8); PG8_WAIT_L(0); PG8_BAR; PG8_MMA(0, 0, At, B0); PG8_MMA(0, 1, At, B1); PG8_BAR; PG8_SCHED;
            PG8_LDA(At, 0, 1); PG8_STAGE(PG8_SB(0, 0), b2, voffB); PG8_STAGE(PG8_SB(0, 1), b2 + hstepB, voffB); PG8_STAGE(PG8_SA(0, 0), a2, voffA);
            PG8_WAIT_V(8); PG8_WAIT_L(0); PG8_BAR; PG8_MMA(1, 0, At, B0); PG8_MMA(1, 1, At, B1); PG8_BAR; PG8_SCHED;
            PG8_LDB(B0, 1, 0); PG8_LDB(B1, 1, 1); PG8_SCHED; PG8_LDA(At, 1, 0); PG8_STAGE(PG8_SA(0, 1), a2 + hstepA, voffA);
            PG8_WAIT_V(8); PG8_WAIT_L(0); PG8_BAR; PG8_MMA(0, 0, At, B0); PG8_MMA(0, 1, At, B1); PG8_BAR; PG8_SCHED;
            PG8_LDA(At, 1, 1); PG8_STAGE(PG8_SB(1, 0), b3, voffB); PG8_STAGE(PG8_SB(1, 1), b3 + hstepB, voffB); PG8_STAGE(PG8_SA(1, 0), a3, voffA);
            PG8_WAIT_V(8); PG8_WAIT_L(0); PG8_BAR; PG8_MMA(1, 0, At, B0); PG8_MMA(1, 1, At, B1); PG8_BAR; PG8_SCHED;
        }
        if constexpr (ALIGN_EPI) { if (wr == 0) PG8_BAR; }
        E(acc, cur, wr, wc, fr, fq);
        if (!has_next) break;
#pragma unroll
        for (int a = 0; a < 2; ++a)
#pragma unroll
            for (int b = 0; b < 2; ++b)
#pragma unroll
                for (int m = 0; m < 4; ++m)
#pragma unroll
                    for (int n = 0; n < 2; ++n) acc[a][b][m][n] = (f32x4){0.f, 0.f, 0.f, 0.f};
        cur = nxt; cA = nA; cB = nB; ++ui;
        if constexpr (ALIGN_EPI) { if (wr == 1) PG8_BAR; }
    }
    PG8_WAIT_V(0);
    if constexpr (!ALIGN_EPI) { if (wr == 0) PG8_BAR; }
    PG8_BAR;
#undef PG8_SA
#undef PG8_SB
#undef PG8_STAGE
#undef PG8_LDA
#undef PG8_LDB
#undef PG8_MMA
#undef PG8_WAIT_V
#undef PG8_WAIT_L
#undef PG8_BAR
#undef PG8_SCHED
}


struct EpiSwiGLU {
    static constexpr bool PERM = true;
    bf16_t* H;
    __device__ __forceinline__ void operator()(const f32x4 (&acc)[2][2][4][2], const Unit& u, int wr, int wc, int fr, int fq) const {
        const int row0 = u.pm * BM + wr * 64 + fr, col0 = u.pn * 128 + wc * 32 + 8 * fq;
#pragma unroll
        for (int ai = 0; ai < 2; ++ai)
#pragma unroll
            for (int m = 0; m < 4; ++m) {
                bf16_t* rowp = H + (size_t)(row0 + ai * HALF + m * 16) * DFF + col0;
                const f32x4 g0 = acc[ai][0][m][0], g1 = acc[ai][0][m][1], u0 = acc[ai][1][m][0], u1 = acc[ai][1][m][1];
                u32x4 w;
                w.x = cvt_pk_bf16(silu_f(g0[0]) * u0[0], silu_f(g0[1]) * u0[1]); w.y = cvt_pk_bf16(silu_f(g0[2]) * u0[2], silu_f(g0[3]) * u0[3]);
                w.z = cvt_pk_bf16(silu_f(g1[0]) * u1[0], silu_f(g1[1]) * u1[1]); w.w = cvt_pk_bf16(silu_f(g1[2]) * u1[2], silu_f(g1[3]) * u1[3]);
                *(u32x4*)rowp = w;
            }
    }
};
struct EpiResid {
    static constexpr bool PERM = false;
    const float* base_lat; float* out_lat; const float* base_ctx; float* out_ctx; const float* gate; float coef;
    __device__ __forceinline__ void operator()(const f32x4 (&acc)[2][2][4][2], const Unit& u, int wr, int wc, int fr, int fq) const {
        const bool lat = u.pm < MLAT / BM; const int cls = lat ? u.pm / (SEQ / BM) : NB;
        const float* base = lat ? base_lat + (size_t)u.pm * BM * DM : base_ctx + (size_t)(u.pm - MLAT / BM) * BM * DM;
        float* out = lat ? out_lat + (size_t)u.pm * BM * DM : out_ctx + (size_t)(u.pm - MLAT / BM) * BM * DM;
        const int col0 = u.pn * BM + wc * 32 + 4 * fq;
        f32x4 gv[2][2];
#pragma unroll
        for (int bj = 0; bj < 2; ++bj)
#pragma unroll
            for (int n = 0; n < 2; ++n) gv[bj][n] = *(const f32x4*)(gate + (size_t)cls * MODLD + col0 + bj * HALF + n * 16) * coef;
#pragma unroll
        for (int ai = 0; ai < 2; ++ai)
#pragma unroll
            for (int m = 0; m < 4; ++m) { const size_t off = (size_t)(ai * HALF + wr * 64 + m * 16 + fr) * DM + col0;
#pragma unroll
                for (int bj = 0; bj < 2; ++bj)
#pragma unroll
                    for (int n = 0; n < 2; ++n) { const f32x4 bs = *(const f32x4*)(base + off + bj * HALF + n * 16);
                        *(f32x4*)(out + off + bj * HALF + n * 16) = bs + gv[bj][n] * acc[ai][bj][m][n]; }
                asm volatile("" ::: "memory"); }
    }
};
struct EpiInProj {
    static constexpr bool PERM = false;
    bf16_t* Q; bf16_t* Kb; bf16_t* VT; bf16_t* DFTB; const float* ropec; const float* ropes;
    __device__ __forceinline__ void operator()(const f32x4 (&acc)[2][2][4][2], const Unit& u, int wr, int wc, int fr, int fq) const {
        if (u.kind <= 1) {
            bf16_t* dst = u.kind == 0 ? Q : Kb; const float sc = u.kind == 0 ? QSCALE : 1.0f;
            const int axis = wc & 1;
#pragma unroll
            for (int ai = 0; ai < 2; ++ai)
#pragma unroll
                for (int m = 0; m < 4; ++m) {
                    const int row = u.pm * BM + ai * HALF + wr * 64 + m * 16 + fr;
                    const bool lat = row < MLAT; const int t = row & (SEQ - 1); const int pos = axis ? (t & 63) : (t >> 6);
                    f32x4 cs = *(const f32x4*)(ropec + pos * 16 + 4 * fq), sn = *(const f32x4*)(ropes + pos * 16 + 4 * fq);
                    if (!lat) { cs = (f32x4){1.f, 1.f, 1.f, 1.f}; sn = (f32x4){0.f, 0.f, 0.f, 0.f}; }
                    bf16_t* rowp = dst + (size_t)row * DQK + u.pn * BM + wc * 32 + 4 * fq;
#pragma unroll
                    for (int bj = 0; bj < 2; ++bj) { const f32x4 x1 = acc[ai][bj][m][0], x2 = acc[ai][bj][m][1];
                        const f32x4 o1 = (x1 * cs - x2 * sn) * sc, o2 = (x2 * cs + x1 * sn) * sc;
                        u32x2 w1, w2; w1.x = cvt_pk_bf16(o1[0], o1[1]); w1.y = cvt_pk_bf16(o1[2], o1[3]); w2.x = cvt_pk_bf16(o2[0], o2[1]); w2.y = cvt_pk_bf16(o2[2], o2[3]);
                        *(u32x2*)(rowp + bj * HALF) = w1; *(u32x2*)(rowp + bj * HALF + 16) = w2; }
                }
        } else {
            bf16_t* base; size_t ld;
            if (u.kind == 2) { base = VT + (size_t)u.pm * BM * MALL + (size_t)u.pn * BM; ld = MALL; }
            else { const int b = u.pn >> 4, n0 = (u.pn & 15) * BM; base = DFTB + (size_t)(b * 256) * 8192 + (size_t)u.pm * 4096 + n0; ld = 8192; }
#pragma unroll
            for (int ai = 0; ai < 2; ++ai)
#pragma unroll
                for (int m = 0; m < 4; ++m) { bf16_t* rowp = base + (size_t)(ai * HALF + wr * 64 + m * 16 + fr) * ld + wc * 32 + 4 * fq;
#pragma unroll
                    for (int bj = 0; bj < 2; ++bj)
#pragma unroll
                        for (int n = 0; n < 2; ++n) { const f32x4 v = acc[ai][bj][m][n]; u32x2 w; w.x = cvt_pk_bf16(v[0], v[1]); w.y = cvt_pk_bf16(v[2], v[3]);
                            *(u32x2*)(rowp + bj * HALF + n * 16) = w; } }
        }
    }
};
struct EpiDFT {
    static constexpr bool PERM = true;
    bf16_t* AO;
    __device__ __forceinline__ void operator()(const f32x4 (&acc)[2][2][4][2], const Unit& u, int wr, int wc, int fr, int fq) const {
        const float sc = 1.0f / 512.0f;
        bf16_t* base = AO + (size_t)(u.pn * SEQ + u.pm * BM + wr * 64 + fr) * DM + DQK + wc * 32 + 8 * fq;
#pragma unroll
        for (int ai = 0; ai < 2; ++ai)
#pragma unroll
            for (int m = 0; m < 4; ++m) { bf16_t* rowp = base + (size_t)(ai * HALF + m * 16) * DM;
#pragma unroll
                for (int bj = 0; bj < 2; ++bj) { const f32x4 v0 = acc[ai][bj][m][0] * sc, v1 = acc[ai][bj][m][1] * sc;
                    u32x4 w; w.x = cvt_pk_bf16(v0[0], v0[1]); w.y = cvt_pk_bf16(v0[2], v0[3]); w.z = cvt_pk_bf16(v1[0], v1[1]); w.w = cvt_pk_bf16(v1[2], v1[3]);
                    *(u32x4*)(rowp + bj * HALF) = w; } }
    }
};
}

struct Args { const float* in[24]; float* out; unsigned char* ws; int ph_lo, ph_hi; };
enum { I_X = 0, I_C, I_CTX, I_CCTX, I_WADA, I_BADA, I_N1G, I_F1G, I_F1U, I_F1D, I_NMG, I_WIN, I_LQ1, I_LK1, I_LQ2, I_LK2, I_SUBG, I_WFOUR, I_WOUT, I_N2G, I_F2G, I_F2U, I_F2D, I_FNG };

__device__ __forceinline__ unsigned f2bf(float f) { unsigned u = __builtin_bit_cast(unsigned, f); return (u + 0x7fffu + ((u >> 16) & 1u)) >> 16; }
__device__ __forceinline__ unsigned pk2(float lo, float hi) { return f2bf(lo) | (f2bf(hi) << 16); }

__device__ __forceinline__ void transpose_item(const float* W, int ldw, int k0, int nsrc0, bf16_t* WT, int ldt, int drow0, int dk0, LAS float* scr, int lane) {
#pragma unroll 8
    for (int i = 0; i < 32; ++i) { const int kk = 2 * i + (lane >> 5); scr[kk * 33 + (lane & 31)] = W[(size_t)(k0 + kk) * ldw + nsrc0 + (lane & 31)]; }
    asm volatile("s_waitcnt lgkmcnt(0)" ::: "memory");
    const int c = lane & 7;
#pragma unroll
    for (int j = 0; j < 4; ++j) { const int n = (lane >> 3) + 8 * j; const LAS float* s = scr + (8 * c) * 33 + n;
        u32x4 o; o.x = pk2(s[0 * 33], s[1 * 33]); o.y = pk2(s[2 * 33], s[3 * 33]); o.z = pk2(s[4 * 33], s[5 * 33]); o.w = pk2(s[6 * 33], s[7 * 33]);
        *(u32x4*)(WT + (size_t)(drow0 + n) * ldt + dk0 + k0 + 8 * c) = o; }
    asm volatile("s_waitcnt lgkmcnt(0)" ::: "memory");
}

__device__ __forceinline__ void prologue(const Args& A, LAS unsigned char* lds, int vcu, int G) {
    const int tid = threadIdx.x, lane = tid & 63, wave = __builtin_amdgcn_readfirstlane(tid >> 6);
    unsigned char* ws = A.ws;
    {
        LAS float* T = (LAS float*)lds;
        for (int i = tid; i < 4096; i += 512) T[i] = cospif((float)i * (1.0f / 2048.0f));
        __syncthreads();
        bf16_t* Mx = (bf16_t*)(ws + WS_DFTM);
        for (int it = vcu; it < 256; it += G) {
            for (int ch = tid; ch < 16 * 1024; ch += 512) {
                const int r = it * 16 + (ch >> 10), k0 = (ch & 1023) * 8;
                const int kk = k0 & 4095, add = (k0 >= 4096) ? 1024 : 0;
                float v[8];
#pragma unroll
                for (int j = 0; j < 8; ++j) v[j] = T[(r * (kk + j) + add) & 4095];
                u32x4 o; o.x = pk2(v[0], v[1]); o.y = pk2(v[2], v[3]); o.z = pk2(v[4], v[5]); o.w = pk2(v[6], v[7]);
                *(u32x4*)(Mx + (size_t)r * 8192 + k0) = o;
            }
        }
        __syncthreads();
    }
    for (int it = vcu; it < 417; it += G) {
        if (it < 288) {
            LAS float* sc = (LAS float*)lds;
            LAS float* red = (LAS float*)(lds + 5 * 1024 * 4);
            for (int i = tid; i < 5 * 1024; i += 512) { const int r = i >> 10, k = i & 1023; const float cv = r < 4 ? A.in[I_C][r * 1024 + k] : A.in[I_CCTX][k]; sc[i] = cv / (1.0f + expf(-cv)); }
            __syncthreads();
            const int n0 = it * 32, nl = tid & 31, kg = tid >> 5;
            float a0 = 0.f, a1 = 0.f, a2 = 0.f, a3 = 0.f, a4 = 0.f;
            const float* wp = A.in[I_WADA] + n0 + nl;
#pragma unroll 4
            for (int kk = 0; kk < 64; ++kk) { const int k = kg + 16 * kk; const float w = wp[(size_t)k * MODLD];
                a0 += sc[k] * w; a1 += sc[1024 + k] * w; a2 += sc[2048 + k] * w; a3 += sc[3072 + k] * w; a4 += sc[4096 + k] * w; }
            red[(0 * 16 + kg) * 32 + nl] = a0; red[(1 * 16 + kg) * 32 + nl] = a1; red[(2 * 16 + kg) * 32 + nl] = a2; red[(3 * 16 + kg) * 32 + nl] = a3; red[(4 * 16 + kg) * 32 + nl] = a4;
            __syncthreads();
            if (tid < 160) { const int r = tid >> 5, n = tid & 31; float s = A.in[I_BADA][n0 + n];
                for (int q = 0; q < 16; ++q) s += red[(r * 16 + q) * 32 + n];
                ((float*)(ws + WS_MOD))[r * MODLD + n0 + n] = s; }
            __syncthreads();
        } else if (it < 352) {
            const int item = it - 288, k0 = (item >> 2) * 64, g = item & 3;
            LAS float* wt = (LAS float*)lds;
            LAS float* tab = (LAS float*)(lds + 64 * 65 * 4);
            for (int i = tid; i < 4096; i += 512) { const int kk = i >> 6, d = i & 63; wt[kk * 65 + d] = A.in[I_WIN][(size_t)(k0 + kk) * 2560 + 2304 + g * 64 + d]; }
            if (tid < 64) tab[tid] = cospif((float)tid * (1.0f / 32.0f));
            __syncthreads();
            const int kk = tid & 63, grp = tid >> 6;
            bf16_t* WF = (bf16_t*)(ws + WS_WF);
            for (int jj = 0; jj < 16; ++jj) {
                const int e = grp * 16 + jj, part = e >> 6, dp = e & 63, add = part ? 48 : 0;
                float s = 0.f;
#pragma unroll 8
                for (int d = 0; d < 64; ++d) s += wt[kk * 65 + d] * tab[(d * dp + add) & 63];
                WF[(size_t)(part * 256 + g * 64 + dp) * DM + k0 + kk] = (bf16_t)f2bf(s);
            }
            __syncthreads();
        } else if (it < 416) {
            const int item = it - 352, n0 = (item >> 2) * 64, j0 = (item & 3) * 64;
            LAS float* wo = (LAS float*)lds;
            for (int i = tid; i < 256 * 64; i += 512) { const int ii = i >> 6, n = i & 63; wo[i] = A.in[I_WOUT][(size_t)(768 + ii) * DM + n0 + n]; }
            __syncthreads();
            bf16_t* WO = (bf16_t*)(ws + WS_WO);
            for (int jj = 0; jj < 8; ++jj) {
                const int j = j0 + wave * 8 + jj; const float* wf = A.in[I_WFOUR] + (size_t)j * 256;
                float s = 0.f;
#pragma unroll 8
                for (int i = 0; i < 256; ++i) s += wf[i] * wo[i * 64 + lane];
                WO[(size_t)(n0 + lane) * DM + 768 + j] = (bf16_t)f2bf(s);
            }
            __syncthreads();
        } else {
            float* rc = (float*)(ws + WS_ROPE); float* rs = rc + 1024;
            for (int i = tid; i < 1024; i += 512) { const int pos = i >> 4, p = i & 15; const float inv = powf(10000.0f, -(float)p / 16.0f); const float ang = (float)pos * inv; rc[i] = cosf(ang); rs[i] = sinf(ang); }
            if (wave == 0) {
                const float d1 = wave_sum(A.in[I_LQ1][lane] * A.in[I_LK1][lane]), d2 = wave_sum(A.in[I_LQ2][lane] * A.in[I_LK2][lane]);
                if (lane == 0) ((float*)(ws + WS_SCAL))[0] = expf(d1) - expf(d2) + LAMBDA_INIT;
            }
        }
    }
    __syncthreads();
    LAS float* scr = (LAS float*)(lds + wave * 16384);
    const int gw = vcu * 8 + wave, NGW = G * 8;
    constexpr int I_GU = 16 * 88, I_DN = 44 * 32, I_IN = 16 * 72, I_OUT = 12 * 32;
    constexpr int NIT = 4 * I_GU + 2 * I_DN + I_IN + I_OUT;
    for (int it = gw; it < NIT; it += NGW) {
        int r = it;
        if (r < 4 * I_GU) {
            const int which = r / I_GU; r -= which * I_GU; const int kb = r / 88, nb = r % 88, n0 = nb * 32;
            const float* W = A.in[which == 0 ? I_F1G : which == 1 ? I_F1U : which == 2 ? I_F2G : I_F2U];
            bf16_t* WT = (bf16_t*)(ws + (which < 2 ? WS_WGU1 : WS_WGU2));
            transpose_item(W, DFF, kb * 64, n0, WT, DM, 256 * (n0 >> 7) + (n0 & 127) + ((which & 1) ? 128 : 0), 0, scr, lane);
            continue;
        }
        r -= 4 * I_GU;
        if (r < 2 * I_DN) {
            const int which = r / I_DN; r -= which * I_DN; const int kb = r / 32, nb = r % 32;
            transpose_item(A.in[which ? I_F2D : I_F1D], DM, kb * 64, nb * 32, (bf16_t*)(ws + (which ? WS_WD2 : WS_WD1)), DFF, nb * 32, 0, scr, lane);
            continue;
        }
        r -= 2 * I_DN;
        if (r < I_IN) { const int kb = r / 72, nb = r % 72; transpose_item(A.in[I_WIN], 2560, kb * 64, nb * 32, (bf16_t*)(ws + WS_WIN), DM, nb * 32, 0, scr, lane); continue; }
        r -= I_IN;
        { const int kb = r / 32, nb = r % 32; transpose_item(A.in[I_WOUT], DM, kb * 64, nb * 32, (bf16_t*)(ws + WS_WO), DM, nb * 32, 0, scr, lane); }
    }
}

template <bool MOD>
__device__ __forceinline__ void rownorm(const float* xrow, const float* g, const float* shift, const float* scale, bf16_t* obf, float* of32, int lane) {
    f32x4 v[4]; float ss = 0.f;
#pragma unroll
    for (int j = 0; j < 4; ++j) { v[j] = ((const f32x4*)xrow)[lane + 64 * j]; ss += (v[j][0] * v[j][0] + v[j][1] * v[j][1]) + (v[j][2] * v[j][2] + v[j][3] * v[j][3]); }
    const float rstd = 1.0f / sqrtf(wave_sum(ss) * (1.0f / DM) + RMS_EPS);
#pragma unroll
    for (int j = 0; j < 4; ++j) {
        const f32x4 gv = ((const f32x4*)g)[lane + 64 * j];
        f32x4 y = v[j] * rstd * gv;
        if (MOD) { const f32x4 sh = ((const f32x4*)shift)[lane + 64 * j], sc = ((const f32x4*)scale)[lane + 64 * j]; y = y * (sc + 1.0f) + sh;
            u32x2 w; w.x = cvt_pk_bf16(y[0], y[1]); w.y = cvt_pk_bf16(y[2], y[3]); ((u32x2*)obf)[lane + 64 * j] = w; }
        else ((f32x4*)of32)[lane + 64 * j] = y;
    }
}

constexpr int AT_KROW = 272, AT_VROW = 144, AT_KBYTES = 64 * AT_KROW, AT_VBYTES = 128 * AT_VROW, AT_BUF = AT_KBYTES + AT_VBYTES;
__device__ __forceinline__ int at_tok0(int b, int t) { return t < 64 ? b * SEQ + 64 * t : MLAT + b * CTXL + 64 * (t - 64); }

__device__ __forceinline__ void attn_phase(const Args& A, LAS unsigned char* lds, int vcu, int G) {
    const int tid = threadIdx.x, lane = tid & 63, r32 = lane & 31, hi = lane >> 5, wid = __builtin_amdgcn_readfirstlane(tid >> 6), qi = wid & 3, c = wid >> 2;
    const bf16_t* Q = (const bf16_t*)(A.ws + WS_Q); const bf16_t* Kg = (const bf16_t*)(A.ws + WS_K); const bf16_t* VT = (const bf16_t*)(A.ws + WS_VT);
    bf16_t* AO = (bf16_t*)(A.ws + WS_AO);
    const float lam = ((const float*)(A.ws + WS_SCAL))[0];
    const int pi_r = (r32 & 0x13) | ((r32 & 4) << 1) | ((r32 & 8) >> 1);
    constexpr int NT = 68;
    const int kr0 = tid >> 4, kc0 = tid & 15, vr0 = tid >> 3, vc0 = tid & 7;
    for (int u = vcu; u < 768; u += G) {
        const int bh = u >> 5, qc = u & 31, b = bh / 6, h = bh % 6;
        const int qrow = b * SEQ + qc * 128 + qi * 32 + r32;
        bf16x8 qf[4];
        { const bf16_t* qp = Q + (size_t)qrow * DQK + h * 128 + c * 64 + hi * 8;
#pragma unroll
          for (int d0 = 0; d0 < 4; ++d0) qf[d0] = *(const bf16x8*)(qp + d0 * 16); }
        const bf16_t* kbase = Kg + h * 128 + kc0 * 8;
        const bf16_t* vbase = VT + (size_t)(h * 128) * MALL + vc0 * 8;
        u32x4 sk0, sk1, sv0, sv1;
        { const int tok0 = at_tok0(b, 0);
          sk0 = *(const u32x4*)(kbase + (size_t)(tok0 + kr0) * DQK); sk1 = *(const u32x4*)(kbase + (size_t)(tok0 + kr0 + 32) * DQK);
          sv0 = *(const u32x4*)(vbase + (size_t)vr0 * MALL + tok0); sv1 = *(const u32x4*)(vbase + (size_t)(vr0 + 64) * MALL + tok0); }
        *(LAS u32x4*)(lds + kr0 * AT_KROW + kc0 * 16) = sk0; *(LAS u32x4*)(lds + (kr0 + 32) * AT_KROW + kc0 * 16) = sk1;
        *(LAS u32x4*)(lds + AT_KBYTES + vr0 * AT_VROW + vc0 * 16) = sv0; *(LAS u32x4*)(lds + AT_KBYTES + (vr0 + 64) * AT_VROW + vc0 * 16) = sv1;
        __syncthreads();
        f32x16 o[4];
#pragma unroll
        for (int i = 0; i < 4; ++i) o[i] = f32x16{};
        float mrow = -1e30f, lrow = 0.f;
        for (int t = 0; t < NT; ++t) {
            LAS unsigned char* buf = lds + (t & 1) * AT_BUF;
            LAS unsigned char* nbuf = lds + ((t + 1) & 1) * AT_BUF;
            if (t + 1 < NT) { const int tok0 = at_tok0(b, t + 1);
                sk0 = *(const u32x4*)(kbase + (size_t)(tok0 + kr0) * DQK); sk1 = *(const u32x4*)(kbase + (size_t)(tok0 + kr0 + 32) * DQK);
                sv0 = *(const u32x4*)(vbase + (size_t)vr0 * MALL + tok0); sv1 = *(const u32x4*)(vbase + (size_t)(vr0 + 64) * MALL + tok0); }
            f32x16 s0 = f32x16{}, s1 = f32x16{};
            { const LAS unsigned char* kb = buf + pi_r * AT_KROW + c * 128 + hi * 16;
#pragma unroll
              for (int d0 = 0; d0 < 4; ++d0) {
                  const bf16x8 k0 = *(const LAS bf16x8*)(kb + d0 * 32), k1 = *(const LAS bf16x8*)(kb + 32 * AT_KROW + d0 * 32);
                  s0 = __builtin_amdgcn_mfma_f32_32x32x16_bf16(k0, qf[d0], s0, 0, 0, 0);
                  s1 = __builtin_amdgcn_mfma_f32_32x32x16_bf16(k1, qf[d0], s1, 0, 0, 0); } }
            float mx = fmaxf(s0[0], s1[0]);
#pragma unroll
            for (int r = 1; r < 16; ++r) mx = fmaxf(mx, fmaxf(s0[r], s1[r]));
            mx = fmaxf(mx, __shfl_xor(mx, 32));
            if (__any(mx > mrow)) {
                const float mn = fmaxf(mrow, mx), al = __builtin_amdgcn_exp2f(mrow - mn);
                lrow *= al; mrow = mn;
#pragma unroll
                for (int i = 0; i < 4; ++i)
#pragma unroll
                    for (int r = 0; r < 16; ++r) o[i][r] *= al;
            }
            float ps = 0.f;
#pragma unroll
            for (int r = 0; r < 16; ++r) { s0[r] = __builtin_amdgcn_exp2f(s0[r] - mrow); s1[r] = __builtin_amdgcn_exp2f(s1[r] - mrow); ps += s0[r] + s1[r]; }
            lrow += ps;
            bf16x8 pf[4];
            { u32x4 w;
              w.x = cvt_pk_bf16(s0[0], s0[1]); w.y = cvt_pk_bf16(s0[2], s0[3]); w.z = cvt_pk_bf16(s0[4], s0[5]); w.w = cvt_pk_bf16(s0[6], s0[7]); pf[0] = __builtin_bit_cast(bf16x8, w);
              w.x = cvt_pk_bf16(s0[8], s0[9]); w.y = cvt_pk_bf16(s0[10], s0[11]); w.z = cvt_pk_bf16(s0[12], s0[13]); w.w = cvt_pk_bf16(s0[14], s0[15]); pf[1] = __builtin_bit_cast(bf16x8, w);
              w.x = cvt_pk_bf16(s1[0], s1[1]); w.y = cvt_pk_bf16(s1[2], s1[3]); w.z = cvt_pk_bf16(s1[4], s1[5]); w.w = cvt_pk_bf16(s1[6], s1[7]); pf[2] = __builtin_bit_cast(bf16x8, w);
              w.x = cvt_pk_bf16(s1[8], s1[9]); w.y = cvt_pk_bf16(s1[10], s1[11]); w.z = cvt_pk_bf16(s1[12], s1[13]); w.w = cvt_pk_bf16(s1[14], s1[15]); pf[3] = __builtin_bit_cast(bf16x8, w); }
            { const LAS unsigned char* vb = buf + AT_KBYTES + r32 * AT_VROW + hi * 16;
#pragma unroll
              for (int i = 0; i < 4; ++i)
#pragma unroll
                  for (int j = 0; j < 4; ++j) { const bf16x8 vf = *(const LAS bf16x8*)(vb + i * 32 * AT_VROW + j * 32);
                      o[i] = __builtin_amdgcn_mfma_f32_32x32x16_bf16(vf, pf[j], o[i], 0, 0, 0); } }
            if (t + 1 < NT) {
                *(LAS u32x4*)(nbuf + kr0 * AT_KROW + kc0 * 16) = sk0; *(LAS u32x4*)(nbuf + (kr0 + 32) * AT_KROW + kc0 * 16) = sk1;
                *(LAS u32x4*)(nbuf + AT_KBYTES + vr0 * AT_VROW + vc0 * 16) = sv0; *(LAS u32x4*)(nbuf + AT_KBYTES + (vr0 + 64) * AT_VROW + vc0 * 16) = sv1; }
            __syncthreads();
        }
        lrow += __shfl_xor(lrow, 32);
        const float inv = 1.0f / lrow;
        LAS float* scr = (LAS float*)lds + (size_t)qi * 4096;
        if (c == 1) {
            const float f = inv * lam;
#pragma unroll
            for (int i = 0; i < 4; ++i)
#pragma unroll
                for (int r = 0; r < 16; ++r) scr[(i * 16 + r) * 64 + lane] = o[i][r] * f;
        }
        __syncthreads();
        if (c == 0) {
            float ss = 0.f;
#pragma unroll
            for (int i = 0; i < 4; ++i)
#pragma unroll
                for (int r = 0; r < 16; ++r) { const float d = o[i][r] * inv - scr[(i * 16 + r) * 64 + lane]; o[i][r] = d; ss += d * d; }
            ss += __shfl_xor(ss, 32);
            const float rn = (1.0f - LAMBDA_INIT) / sqrtf(ss * (1.0f / 128.0f) + RMS_EPS);
            bf16_t* orow = AO + (size_t)qrow * DM + h * 128 + 4 * hi;
            const float* sg = A.in[I_SUBG] + 4 * hi;
#pragma unroll
            for (int i = 0; i < 4; ++i)
#pragma unroll
                for (int rq = 0; rq < 4; ++rq) { const f32x4 gq = *(const f32x4*)(sg + 32 * i + 8 * rq);
                    u32x2 w; w.x = cvt_pk_bf16(o[i][4 * rq] * rn * gq[0], o[i][4 * rq + 1] * rn * gq[1]); w.y = cvt_pk_bf16(o[i][4 * rq + 2] * rn * gq[2], o[i][4 * rq + 3] * rn * gq[3]);
                    *(u32x2*)(orow + 32 * i + 8 * rq) = w; }
        }
        __syncthreads();
    }
}

__global__ void __launch_bounds__(512, 2) mk_fwd(Args A) {
    extern __shared__ __attribute__((aligned(16))) unsigned char lds_raw[];
    LAS unsigned char* lds = (LAS unsigned char*)lds_raw;
    const int tid = threadIdx.x, lane = tid & 63, wave = __builtin_amdgcn_readfirstlane(tid >> 6);
    const int G = gridDim.x, bx = blockIdx.x, vcu = (G % 8 == 0) ? (bx % 8) * (G / 8) + bx / 8 : bx;
    unsigned char* ws = A.ws;
    const float* mod = (const float*)(ws + WS_MOD);
    bf16_t* XN = (bf16_t*)(ws + WS_XN); bf16_t* Hb = (bf16_t*)(ws + WS_H);
    float* X1C = (float*)(ws + WS_X1C);
    const int lo = A.ph_lo, hi = A.ph_hi;
    const int gw = vcu * 8 + wave, NGW = G * 8;
#define IN(k) (lo <= (k) && (k) < hi)
#define SEAM(k) do { if (IN(k) && IN((k) + 1)) cg::this_grid().sync(); } while (0)

    if (IN(0)) { prologue(A, lds, vcu, G); }
    SEAM(0);
    if (IN(1)) {
        for (int m = gw; m < MALL; m += NGW) { const bool lat = m < MLAT; const int cls = lat ? m / SEQ : NB;
            rownorm<true>(lat ? A.in[I_X] + (size_t)m * DM : A.in[I_CTX] + (size_t)(m - MLAT) * DM, A.in[I_N1G], mod + cls * MODLD + 0 * DM, mod + cls * MODLD + 1 * DM, XN + (size_t)m * DM, nullptr, lane); }
    }
    SEAM(1);
    if (IN(2)) {
        pg8::Order S{}; S.nseg = 1; S.G = G; S.c = bx; S.s0 = pg8::Seg{MALL / 256, 22, 0, (const char*)XN, (const char*)(ws + WS_WGU1), (size_t)256 * DM * 2, (size_t)256 * DM * 2}; S.total = (MALL / 256) * 22;
        pg8::EpiSwiGLU E{Hb};
        pg8::gemm_phase(lds, pg8::Gemm{DM, DM, DM}, S, E);
    }
    SEAM(2);
    if (IN(3)) {
        pg8::Order S{}; S.nseg = 1; S.G = G; S.c = bx; S.s0 = pg8::Seg{MALL / 256, 4, 0, (const char*)Hb, (const char*)(ws + WS_WD1), (size_t)256 * DFF * 2, (size_t)256 * DFF * 2}; S.total = (MALL / 256) * 4;
        pg8::EpiResid E{A.in[I_X], A.out, A.in[I_CTX], X1C, mod + 2 * DM, 0.5f};
        pg8::gemm_phase(lds, pg8::Gemm{DFF, DFF, DFF}, S, E);
    }
    SEAM(3);
    if (IN(4)) {
        for (int m = gw; m < MALL; m += NGW) { const bool lat = m < MLAT; const int cls = lat ? m / SEQ : NB;
            rownorm<true>(lat ? A.out + (size_t)m * DM : X1C + (size_t)(m - MLAT) * DM, A.in[I_NMG], mod + cls * MODLD + 3 * DM, mod + cls * MODLD + 4 * DM, XN + (size_t)m * DM, nullptr, lane); }
    }
    SEAM(4);
    if (IN(5)) {
        const char* WIN = (const char*)(ws + WS_WIN); const size_t T = (size_t)256 * DM * 2;
        pg8::Order S{}; S.nseg = 4; S.G = G; S.c = bx;
        S.s0 = pg8::Seg{MLAT / 256, 3, 0, (const char*)XN, WIN, T, T};
        S.s1 = pg8::Seg{MALL / 256, 3, 1, (const char*)XN, WIN + 3 * T, T, T};
        S.s2 = pg8::Seg{3, MALL / 256, 2, WIN + 6 * T, (const char*)XN, T, T};
        S.s3 = pg8::Seg{2, MLAT / 256, 3, (const char*)(ws + WS_WF), (const char*)XN, T, T};
        S.total = 64 * 3 + 68 * 3 + 3 * 68 + 2 * 64;
        pg8::EpiInProj E{(bf16_t*)(ws + WS_Q), (bf16_t*)(ws + WS_K), (bf16_t*)(ws + WS_VT), (bf16_t*)(ws + WS_DFTB), (const float*)(ws + WS_ROPE), (const float*)(ws + WS_ROPE) + 1024};
        pg8::gemm_phase(lds, pg8::Gemm{DM, DM, DM}, S, E);
    }
    SEAM(5);
    if (IN(6)) {
        attn_phase(A, lds, vcu, G);
        pg8::Order S{}; S.nseg = 1; S.G = G; S.c = bx; S.s0 = pg8::Seg{16, 4, 0, (const char*)(ws + WS_DFTM), (const char*)(ws + WS_DFTB), (size_t)256 * 8192 * 2, (size_t)256 * 8192 * 2}; S.total = 64;
        pg8::EpiDFT E{(bf16_t*)(ws + WS_AO)};
        pg8::gemm_phase(lds, pg8::Gemm{8192, 8192, 8192}, S, E);
    }
    SEAM(6);
    if (IN(7)) {
        pg8::Order S{}; S.nseg = 1; S.G = G; S.c = bx; S.s0 = pg8::Seg{MLAT / 256, 4, 0, (const char*)(ws + WS_AO), (const char*)(ws + WS_WO), (size_t)256 * DM * 2, (size_t)256 * DM * 2}; S.total = 256;
        pg8::EpiResid E{A.out, A.out, nullptr, nullptr, mod + 5 * DM, 1.0f};
        pg8::gemm_phase(lds, pg8::Gemm{DM, DM, DM}, S, E);
    }
    SEAM(7);
    if (IN(8)) {
        for (int m = gw; m < MLAT; m += NGW) { const int cls = m / SEQ;
            rownorm<true>(A.out + (size_t)m * DM, A.in[I_N2G], mod + cls * MODLD + 6 * DM, mod + cls * MODLD + 7 * DM, XN + (size_t)m * DM, nullptr, lane); }
    }
    SEAM(8);
    if (IN(9)) {
        pg8::Order S{}; S.nseg = 1; S.G = G; S.c = bx; S.s0 = pg8::Seg{MLAT / 256, 22, 0, (const char*)XN, (const char*)(ws + WS_WGU2), (size_t)256 * DM * 2, (size_t)256 * DM * 2}; S.total = 64 * 22;
        pg8::EpiSwiGLU E{Hb};
        pg8::gemm_phase(lds, pg8::Gemm{DM, DM, DM}, S, E);
    }
    SEAM(9);
    if (IN(10)) {
        pg8::Order S{}; S.nseg = 1; S.G = G; S.c = bx; S.s0 = pg8::Seg{MLAT / 256, 4, 0, (const char*)Hb, (const char*)(ws + WS_WD2), (size_t)256 * DFF * 2, (size_t)256 * DFF * 2}; S.total = 256;
        pg8::EpiResid E{A.out, A.out, nullptr, nullptr, mod + 8 * DM, 0.5f};
        pg8::gemm_phase(lds, pg8::Gemm{DFF, DFF, DFF}, S, E);
    }
    SEAM(10);
    if (IN(11)) {
        for (int m = gw; m < MLAT; m += NGW) rownorm<false>(A.out + (size_t)m * DM, A.in[I_FNG], nullptr, nullptr, nullptr, A.out + (size_t)m * DM, lane);
    }
#undef IN
#undef SEAM
}

extern "C" void kernel_launch(void* const* d_in, const int* in_sizes, int n_in, void* d_out, int out_size, void* d_ws, size_t ws_size, hipStream_t stream) {
    static int grid = 0;
    if (grid == 0) {
        if (n_in != 24 || out_size != MLAT * DM || ws_size < WS_END) { fprintf(stderr, "kernel_launch: unexpected shapes (n_in %d out %d ws %zu)\n", n_in, out_size, ws_size); grid = -1; return; }
        int dev = 0, cus = 0, per_cu = 0;
        hipGetDevice(&dev); hipDeviceGetAttribute(&cus, hipDeviceAttributeMultiprocessorCount, dev);
        hipFuncSetAttribute((const void*)mk_fwd, hipFuncAttributeMaxDynamicSharedMemorySize, LDS_BYTES);
        hipOccupancyMaxActiveBlocksPerMultiprocessor(&per_cu, (const void*)mk_fwd, 512, LDS_BYTES);
        if (per_cu < 1) { fprintf(stderr, "kernel_launch: occupancy query says %d blocks per CU\n", per_cu); per_cu = 1; }
        (void)hipGetLastError();
        grid = cus;
        if (grid % 8) grid -= grid % 8;
    }
    if (grid < 0) return;
    Args a{};
    for (int i = 0; i < 24; ++i) a.in[i] = (const float*)d_in[i];
    a.out = (float*)d_out; a.ws = (unsigned char*)d_ws;
#if MK_N_LAUNCHES == 1
    a.ph_lo = 0; a.ph_hi = NPH;
    void* args[] = {&a};
    hipError_t e = hipLaunchCooperativeKernel((const void*)mk_fwd, dim3(grid), dim3(512), args, LDS_BYTES, stream);
    if (e != hipSuccess) fprintf(stderr, "cooperative launch failed: %s (grid %d)\n", hipGetErrorString(e), grid);
#else
    for (int p = 0; p < NPH; ++p) { a.ph_lo = p; a.ph_hi = p + 1; hipLaunchKernelGGL(mk_fwd, dim3(grid), dim3(512), LDS_BYTES, stream, a); }
#endif
}
```

```cpp
#include <hip/hip_runtime.h>
#include <hip/hip_cooperative_groups.h>
#include <cstdio>
#include <cstdint>
namespace cg = cooperative_groups;

#ifndef MK_N_LAUNCHES
#define MK_N_LAUNCHES 1
#endif

#define LAS __attribute__((address_space(3)))
typedef unsigned short bf16_t;
typedef short bf16x8 __attribute__((ext_vector_type(8)));
typedef float f32x4 __attribute__((ext_vector_type(4)));
typedef float f32x2 __attribute__((ext_vector_type(2)));
typedef float f32x16 __attribute__((ext_vector_type(16)));
typedef unsigned u32x4 __attribute__((ext_vector_type(4)));
typedef unsigned u32x2 __attribute__((ext_vector_type(2)));

constexpr int DM = 1024, NB = 4, SEQ = 4096, CTXL = 256, MLAT = NB * SEQ, MCTX = NB * CTXL, MALL = MLAT + MCTX;
constexpr int DFF = 2816, MODLD = 9216, DQK = 768;
constexpr int NPH = 12;
constexpr float RMS_EPS = 1e-6f;
constexpr float QSCALE = 0.125f * 1.4426950408889634f;
constexpr float LAMBDA_INIT = 0.2f;

constexpr size_t MiB = 1u << 20;
constexpr size_t WS_SCAL = 0, WS_MOD = 4096, WS_ROPE = 256 * 1024, WS_BAR = 512 * 1024, BAR_BYTES = 16384, WS_M1 = 576 * 1024, WS_M2 = 640 * 1024, WS_TW = 704 * 1024;
constexpr size_t HM = MiB / 2;
constexpr size_t WS_WGU1 = 2 * HM, WS_WD1 = 24 * HM, WS_WGU2 = 35 * HM, WS_WD2 = 57 * HM, WS_WIN = 68 * HM, WS_WF = 77 * HM, WS_WO = 79 * HM;
constexpr size_t WS_DFTM = 83 * HM, WS_YT = WS_DFTM, WS_XN = 211 * HM, WS_AO = WS_XN, WS_H = 279 * HM;
constexpr size_t WS_Q = 279 * HM, WS_K = 327 * HM, WS_VT = 378 * HM, WS_DFTB = 429 * HM;
constexpr size_t WS_PART = 466 * HM, WS_XBUF = 510 * HM, WS_END = 512 * HM;
static_assert(WS_H + (size_t)17408 * 2816 * 2 <= WS_PART && WS_DFTB + 16 * MiB <= WS_PART && WS_XN + 34 * MiB <= WS_H && WS_DFTM + 64 * MiB <= WS_XN && WS_WO + 2 * MiB <= WS_DFTM, "ws map");

constexpr int LDS_BYTES = 132096;

__device__ __forceinline__ unsigned cvt_pk_bf16(float lo, float hi) { unsigned r; asm volatile("v_cvt_pk_bf16_f32 %0, %1, %2" : "=v"(r) : "v"(lo), "v"(hi)); return r; }
__device__ __forceinline__ float wave_sum(float v) {
#pragma unroll
    for (int o = 1; o < 64; o <<= 1) v += __shfl_xor(v, o);
    return v;
}
__device__ __forceinline__ float silu_f(float g) { return g * __builtin_amdgcn_rcpf(1.0f + __builtin_amdgcn_exp2f(-1.4426950408889634f * g)); }

namespace pg8 {
constexpr int BM = 256, BK = 64, HALF = 128, HTB = HALF * BK * 2, STAGE_BYTES = 8 * HTB, WGM = 4;
__host__ __device__ __forceinline__ int lds_byte(int r, int c) { const int st = (r >> 4) * 2 + (c >> 5), rr = r & 15, cc = c & 31, ob = rr * 64 + cc * 2; return st * 1024 + (ob ^ (((ob >> 9) & 1) << 5)); }
__host__ __device__ __forceinline__ void stage_rc(int b, int& R, int& C) { const int st = b / 1024, sb = b % 1024, swz = sb ^ (((sb >> 9) & 1) << 5); R = (st >> 1) * 16 + swz / 64; C = (st & 1) * 32 + (swz % 64) / 2; }
__host__ __device__ __forceinline__ int perm32(int rho) { const int n = rho >> 4, i = rho & 15; return 8 * (i >> 2) + 4 * n + (i & 3); }

struct Unit { int pm, pn, kind, ks; const char* a; const char* b; };
struct Gemm { int K, lda, ldb; };

struct Seg { int nM, nN, kind; const char* a; const char* b; size_t ta, tb; int nks; size_t ka, kb; };
__device__ __forceinline__ bool seg_take(const Seg& s, int& w, Unit& u) {
    const int nks = s.nks > 1 ? s.nks : 1; const int n = s.nM * s.nN * nks;
    if (w >= n) { w -= n; return false; }
    const int ks = w % nks; w /= nks; u.ks = ks;
    const int nig = WGM * s.nN, gid = w / nig, fm = gid * WGM, gsz = (s.nM - fm) < WGM ? (s.nM - fm) : WGM;
    u.pm = fm + ((w % nig) % gsz); u.pn = (w % nig) / gsz; u.kind = s.kind;
    u.a = s.a + (size_t)u.pm * s.ta + (size_t)ks * s.ka; u.b = s.b + (size_t)u.pn * s.tb + (size_t)ks * s.kb;
    if (s.kind == 3) u.b = s.b + (size_t)((u.pn >> 4) * SEQ + (u.pn & 15) * 4) * (DM * 2);
    return true;
}
struct Order {
    Seg s0, s1, s2, s3; int nseg, G, c, total;
    __device__ __forceinline__ bool next(int i, Unit& u) const {
        const long L = (long)i * G + c; if (L >= total) return false;
        int w = (int)L; { const int q = total / 8, r = total % 8, xcd = w % 8, off = w / 8; w = (xcd < r ? xcd * (q + 1) : r * (q + 1) + (xcd - r) * q) + off; }
        if (seg_take(s0, w, u)) return true;
        if (nseg > 1 && seg_take(s1, w, u)) return true;
        if (nseg > 2 && seg_take(s2, w, u)) return true;
        if (nseg > 3 && seg_take(s3, w, u)) return true;
        return false;
    }
};

template <class Epi, bool BSEL = false>
__device__ __forceinline__ void gemm_phase(LAS unsigned char* lds, const Gemm g, const Order& S, const Epi& E, const int tid) {
    constexpr bool ALIGN_EPI = true;
    const int wid = __builtin_amdgcn_readfirstlane(tid >> 6), lane = tid & 63, wr = wid >> 2, wc = wid & 3, fr = lane & 15, fq = lane >> 4;
    const int K = g.K, nt = K / BK;
    unsigned voffA[2], voffB[2], voffBp[2];
#pragma unroll
    for (int i = 0; i < 2; ++i) { int R, C; stage_rc(tid * 16 + i * 8192, R, C); const int Rb = Epi::PERM ? ((R & ~31) + perm32(R & 31)) : R;
        voffA[i] = (unsigned)(R * g.lda + C) * 2u; voffB[i] = (unsigned)(Rb * g.ldb + C) * 2u;
        voffBp[i] = (unsigned)((64 * (Rb & 63) + (Rb >> 6)) * g.ldb + C) * 2u; }
    const size_t kstep = (size_t)(BK * 2);
    const size_t hstepA = (size_t)HALF * g.lda * 2, hstepBn = (size_t)HALF * g.ldb * 2, hstepBp = (size_t)2 * g.ldb * 2;
    const unsigned ldsw = (unsigned)wid * 1024u;
    const int aoff = lds_byte(wr * 64 + fr, fq * 8), boff = lds_byte(wc * 32 + fr, fq * 8);
#define PG8_SA(b, h) (((b) * 2 + (h)) * HTB)
#define PG8_SB(b, h) ((4 + (b) * 2 + (h)) * HTB)
#define PG8_STAGE(bufoff, gbase, voff) do { _Pragma("unroll") for (int _i = 0; _i < 2; ++_i) \
        __builtin_amdgcn_global_load_lds((const unsigned*)((const char*)(gbase) + (voff)[_i]), (LAS unsigned*)(lds + (bufoff) + ldsw + _i * 8192), 16, 0, 0); } while (0)
#define PG8_STAGEB(bufoff, gbase, perm) do { _Pragma("unroll") for (int _i = 0; _i < 2; ++_i) \
        __builtin_amdgcn_global_load_lds((const unsigned*)((const char*)(gbase) + ((BSEL && (perm)) ? voffBp[_i] : voffB[_i])), (LAS unsigned*)(lds + (bufoff) + ldsw + _i * 8192), 16, 0, 0); } while (0)
#define PG8_LDA(dst, b, h) do { _Pragma("unroll") for (int m = 0; m < 4; ++m) _Pragma("unroll") for (int k = 0; k < 2; ++k) dst[m][k] = *(const LAS bf16x8*)(lds + PG8_SA(b, h) + aoff + m * 2048 + k * 1024); } while (0)
#define PG8_LDB(dst, b, h) do { _Pragma("unroll") for (int n = 0; n < 2; ++n) _Pragma("unroll") for (int k = 0; k < 2; ++k) dst[n][k] = *(const LAS bf16x8*)(lds + PG8_SB(b, h) + boff + n * 2048 + k * 1024); } while (0)
#define PG8_MMA(ai, bj, At, Bt) do { __builtin_amdgcn_s_setprio(1); _Pragma("unroll") for (int m = 0; m < 4; ++m) _Pragma("unroll") for (int n = 0; n < 2; ++n) _Pragma("unroll") for (int k = 0; k < 2; ++k) \
        acc[ai][bj][m][n] = __builtin_amdgcn_mfma_f32_16x16x32_bf16(Bt[n][k], At[m][k], acc[ai][bj][m][n], 0, 0, 0); __builtin_amdgcn_s_setprio(0); } while (0)
#define PG8_WAIT_V(n) asm volatile("s_waitcnt vmcnt(" #n ")" ::: "memory")
#define PG8_WAIT_L(n) asm volatile("s_waitcnt lgkmcnt(" #n ")" ::: "memory")
#define PG8_BAR __builtin_amdgcn_s_barrier()
#define PG8_SCHED __builtin_amdgcn_sched_barrier(0)
    Unit cur, nxt; int ui = 0;
    if (!S.next(0, cur)) return;
    f32x4 acc[2][2][4][2];
#pragma unroll
    for (int a = 0; a < 2; ++a)
#pragma unroll
        for (int b = 0; b < 2; ++b)
#pragma unroll
            for (int m = 0; m < 4; ++m)
#pragma unroll
                for (int n = 0; n < 2; ++n) acc[a][b][m][n] = (f32x4){0.f, 0.f, 0.f, 0.f};
    bf16x8 At[4][2], B0[2][2], B1[2][2];
    const char* cA = cur.a; const char* cB = cur.b;
    bool cP = BSEL && cur.kind == 3; size_t chB = cP ? hstepBp : hstepBn;
    PG8_STAGEB(PG8_SB(0, 0), cB, cP); PG8_STAGEB(PG8_SB(0, 1), cB + chB, cP); PG8_STAGE(PG8_SA(0, 0), cA, voffA); PG8_STAGE(PG8_SA(0, 1), cA + hstepA, voffA);
    if (wr == 1) PG8_BAR;
    PG8_WAIT_V(2); PG8_BAR;
    PG8_STAGEB(PG8_SB(1, 0), cB + kstep, cP); PG8_STAGE(PG8_SA(1, 0), cA + kstep, voffA); PG8_STAGEB(PG8_SB(1, 1), cB + chB + kstep, cP);
    PG8_WAIT_V(6); PG8_BAR;
    for (;;) {
        const bool has_next = S.next(ui + 1, nxt);
        const char* nA = has_next ? nxt.a : cA; const char* nB = has_next ? nxt.b : cB;
        const bool nP = has_next ? (BSEL && nxt.kind == 3) : cP; const size_t nhB = nP ? hstepBp : hstepBn;
        for (int t = 0; t < nt; t += 2) {
            const bool last = (t == nt - 2);
            const char* a1 = cA + (size_t)(t + 1) * kstep;
            const char* a2 = last ? nA : cA + (size_t)(t + 2) * kstep; const char* b2 = last ? nB : cB + (size_t)(t + 2) * kstep;
            const char* a3 = a2 + kstep; const char* b3 = b2 + kstep;
            const bool p2 = last ? nP : cP; const size_t h2 = last ? nhB : chB;
            PG8_LDB(B0, 0, 0); PG8_LDB(B1, 0, 1); PG8_SCHED; PG8_LDA(At, 0, 0); PG8_STAGE(PG8_SA(1, 1), a1 + hstepA, voffA);
            PG8_WAIT_V(8); PG8_WAIT_L(0); PG8_BAR; PG8_MMA(0, 0, At, B0); PG8_MMA(0, 1, At, B1); PG8_BAR; PG8_SCHED;
            PG8_LDA(At, 0, 1); PG8_STAGEB(PG8_SB(0, 0), b2, p2); PG8_STAGEB(PG8_SB(0, 1), b2 + h2, p2); PG8_STAGE(PG8_SA(0, 0), a2, voffA);
            PG8_WAIT_V(8); PG8_WAIT_L(0); PG8_BAR; PG8_MMA(1, 0, At, B0); PG8_MMA(1, 1, At, B1); PG8_BAR; PG8_SCHED;
            PG8_LDB(B0, 1, 0); PG8_LDB(B1, 1, 1); PG8_SCHED; PG8_LDA(At, 1, 0); PG8_STAGE(PG8_SA(0, 1), a2 + hstepA, voffA);
            PG8_WAIT_V(8); PG8_WAIT_L(0); PG8_BAR; PG8_MMA(0, 0, At, B0); PG8_MMA(0, 1, At, B1); PG8_BAR; PG8_SCHED;
            PG8_LDA(At, 1, 1); PG8_STAGEB(PG8_SB(1, 0), b3, p2); PG8_STAGEB(PG8_SB(1, 1), b3 + h2, p2); PG8_STAGE(PG8_SA(1, 0), a3, voffA);
            PG8_WAIT_V(8); PG8_WAIT_L(0); PG8_BAR; PG8_MMA(1, 0, At, B0); PG8_MMA(1, 1, At, B1); PG8_BAR; PG8_SCHED;
        }
        if constexpr (ALIGN_EPI) { if (wr == 0) PG8_BAR; }
        if constexpr (!Epi::AFTER_DRAIN) E(acc, cur, wr, wc, fr, fq);
        if (!has_next) break;
#pragma unroll
        for (int a = 0; a < 2; ++a)
#pragma unroll
            for (int b = 0; b < 2; ++b)
#pragma unroll
                for (int m = 0; m < 4; ++m)
#pragma unroll
                    for (int n = 0; n < 2; ++n) acc[a][b][m][n] = (f32x4){0.f, 0.f, 0.f, 0.f};
        cur = nxt; cA = nA; cB = nB; cP = nP; chB = nhB; ++ui;
        if constexpr (ALIGN_EPI) { if (wr == 1) PG8_BAR; }
    }
    PG8_WAIT_V(0);
    if constexpr (!ALIGN_EPI) { if (wr == 0) PG8_BAR; }
    PG8_BAR;
    if constexpr (Epi::AFTER_DRAIN) E.fused(acc, cur, wr, wc, fr, fq, lds, tid);
#undef PG8_SA
#undef PG8_SB
#undef PG8_STAGE
#undef PG8_STAGEB
#undef PG8_LDA
#undef PG8_LDB
#undef PG8_MMA
#undef PG8_WAIT_V
#undef PG8_WAIT_L
#undef PG8_BAR
#undef PG8_SCHED
}


struct EpiSwiGLU {
    static constexpr bool PERM = true, AFTER_DRAIN = false;
    bf16_t* H;
    __device__ __forceinline__ void operator()(const f32x4 (&acc)[2][2][4][2], const Unit& u, int wr, int wc, int fr, int fq) const {
        const int row0 = u.pm * BM + wr * 64 + fr, col0 = u.pn * 128 + wc * 32 + 8 * fq;
#pragma unroll
        for (int ai = 0; ai < 2; ++ai)
#pragma unroll
            for (int m = 0; m < 4; ++m) {
                bf16_t* rowp = H + (size_t)(row0 + ai * HALF + m * 16) * DFF + col0;
                const f32x4 g0 = acc[ai][0][m][0], g1 = acc[ai][0][m][1], u0 = acc[ai][1][m][0], u1 = acc[ai][1][m][1];
                u32x4 w;
                w.x = cvt_pk_bf16(silu_f(g0[0]) * u0[0], silu_f(g0[1]) * u0[1]); w.y = cvt_pk_bf16(silu_f(g0[2]) * u0[2], silu_f(g0[3]) * u0[3]);
                w.z = cvt_pk_bf16(silu_f(g1[0]) * u1[0], silu_f(g1[1]) * u1[1]); w.w = cvt_pk_bf16(silu_f(g1[2]) * u1[2], silu_f(g1[3]) * u1[3]);
                *(u32x4*)rowp = w;
            }
    }
};
struct EpiResid {
    static constexpr bool PERM = false, AFTER_DRAIN = false;
    const float* base_lat; float* out_lat; const float* base_ctx; float* out_ctx; const float* gate; float coef;
    __device__ __forceinline__ void operator()(const f32x4 (&acc)[2][2][4][2], const Unit& u, int wr, int wc, int fr, int fq) const {
        const bool lat = u.pm < MLAT / BM; const int cls = lat ? u.pm / (SEQ / BM) : NB;
        const float* base = lat ? base_lat + (size_t)u.pm * BM * DM : base_ctx + (size_t)(u.pm - MLAT / BM) * BM * DM;
        float* out = lat ? out_lat + (size_t)u.pm * BM * DM : out_ctx + (size_t)(u.pm - MLAT / BM) * BM * DM;
        const int col0 = u.pn * BM + wc * 32 + 4 * fq;
        f32x4 gv[2][2];
#pragma unroll
        for (int bj = 0; bj < 2; ++bj)
#pragma unroll
            for (int n = 0; n < 2; ++n) gv[bj][n] = *(const f32x4*)(gate + (size_t)cls * MODLD + col0 + bj * HALF + n * 16) * coef;
#pragma unroll
        for (int ai = 0; ai < 2; ++ai)
#pragma unroll
            for (int m = 0; m < 4; ++m) { const size_t off = (size_t)(ai * HALF + wr * 64 + m * 16 + fr) * DM + col0;
#pragma unroll
                for (int bj = 0; bj < 2; ++bj)
#pragma unroll
                    for (int n = 0; n < 2; ++n) { const f32x4 bs = *(const f32x4*)(base + off + bj * HALF + n * 16);
                        *(f32x4*)(out + off + bj * HALF + n * 16) = bs + gv[bj][n] * acc[ai][bj][m][n]; }
                asm volatile("" ::: "memory"); }
    }
};
struct EpiCtxPart {
    static constexpr bool PERM = true, AFTER_DRAIN = false;
    bf16_t* PART; const float* gate; float coef;
    __device__ __forceinline__ void operator()(const f32x4 (&acc)[2][2][4][2], const Unit& u, int wr, int wc, int fr, int fq) const {
        const int col0 = u.pn * BM + wc * 32 + 8 * fq;
        const __amdgpu_buffer_rsrc_t rsrc = __builtin_amdgcn_make_buffer_rsrc(PART, 0, 11 * MCTX * DM * 2, 0x00020000);
        f32x4 gv[2][2];
#pragma unroll
        for (int bj = 0; bj < 2; ++bj)
#pragma unroll
            for (int n = 0; n < 2; ++n) gv[bj][n] = *(const f32x4*)(gate + (size_t)NB * MODLD + col0 + bj * HALF + n * 4) * coef;
#pragma unroll
        for (int ai = 0; ai < 2; ++ai)
#pragma unroll
            for (int m = 0; m < 4; ++m) { const unsigned rowo = (unsigned)(((size_t)u.ks * MCTX + (u.pm * BM + ai * HALF + wr * 64 + m * 16 + fr)) * DM + col0) * 2u;
#pragma unroll
                for (int bj = 0; bj < 2; ++bj) { const f32x4 v0 = gv[bj][0] * acc[ai][bj][m][0], v1 = gv[bj][1] * acc[ai][bj][m][1];
                    u32x4 w; w.x = cvt_pk_bf16(v0[0], v0[1]); w.y = cvt_pk_bf16(v0[2], v0[3]); w.z = cvt_pk_bf16(v1[0], v1[1]); w.w = cvt_pk_bf16(v1[2], v1[3]);
                    __builtin_amdgcn_raw_buffer_store_b128(w, rsrc, rowo + bj * HALF * 2, 0, 16); } }
    }
};
template <int MODE, bool BBF> struct EpiResidNorm {
    static constexpr bool PERM = true, AFTER_DRAIN = true;
    const float* base; float* out; const float* gate; float coef; const float* g; const float* shift; const float* scale; bf16_t* XN; float* xbuf; unsigned* cnt; bf16_t* XB;
    __device__ __forceinline__ void fused(f32x4 (&acc)[2][2][4][2], const Unit& u, int wr, int wc, int fr, int fq, LAS unsigned char* lds, int tid) const {
        const float* base = this->base; float* out = this->out; const float* gate = this->gate; const float* g = this->g; const float* shift = this->shift; const float* scale = this->scale;
        bf16_t* XN = this->XN; float* xbuf = this->xbuf; unsigned* cnt = this->cnt; float coef = this->coef; bf16_t* XB = this->XB;
        asm volatile("" : "+s"(base), "+s"(out), "+s"(gate), "+s"(g), "+s"(shift), "+s"(scale), "+s"(XN), "+s"(xbuf), "+s"(cnt), "+s"(coef), "+s"(XB));
        bf16_t* xb_ = XB + (size_t)u.pm * BM * DM;
        const int cls = u.pm / (SEQ / BM);
        const float* bs_ = base + (size_t)u.pm * BM * DM; float* out_ = out + (size_t)u.pm * BM * DM;
        const int col0 = u.pn * BM + wc * 32 + 8 * fq;
        LAS float* P = (LAS float*)lds;
        LAS float* S = (LAS float*)(lds + 4096);
        {
            f32x4 gv[2][2];
#pragma unroll
            for (int bj = 0; bj < 2; ++bj)
#pragma unroll
                for (int n = 0; n < 2; ++n) gv[bj][n] = *(const f32x4*)(gate + (size_t)cls * MODLD + col0 + bj * HALF + n * 4) * coef;
#pragma unroll
            for (int ai = 0; ai < 2; ++ai)
#pragma unroll
                for (int m = 0; m < 4; ++m) { const size_t off = (size_t)(ai * HALF + wr * 64 + m * 16 + fr) * DM + col0; float q = 0.f;
#pragma unroll
                    for (int bj = 0; bj < 2; ++bj) { f32x4 b0, b1;
                        if (BBF) { const u32x4 w = *(const u32x4*)(xb_ + off + bj * HALF);
                            b0 = (f32x4){__uint_as_float(w.x << 16), __uint_as_float(w.x & 0xffff0000u), __uint_as_float(w.y << 16), __uint_as_float(w.y & 0xffff0000u)};
                            b1 = (f32x4){__uint_as_float(w.z << 16), __uint_as_float(w.z & 0xffff0000u), __uint_as_float(w.w << 16), __uint_as_float(w.w & 0xffff0000u)}; }
                        else { b0 = *(const f32x4*)(bs_ + off + bj * HALF); b1 = *(const f32x4*)(bs_ + off + bj * HALF + 4); }
                        const f32x4 x0 = b0 + gv[bj][0] * acc[ai][bj][m][0], x1 = b1 + gv[bj][1] * acc[ai][bj][m][1]; acc[ai][bj][m][0] = x0; acc[ai][bj][m][1] = x1;
                        q += ((x0[0] * x0[0] + x0[1] * x0[1]) + (x0[2] * x0[2] + x0[3] * x0[3])) + ((x1[0] * x1[0] + x1[1] * x1[1]) + (x1[2] * x1[2] + x1[3] * x1[3])); }
                    q += __shfl_xor(q, 16); q += __shfl_xor(q, 32);
                    if (fq == 0) P[(ai * HALF + wr * 64 + m * 16 + fr) * 4 + wc] = q;
                    asm volatile("" ::: "memory"); }
        }
        asm volatile("s_waitcnt lgkmcnt(0)" ::: "memory"); __builtin_amdgcn_s_barrier(); asm volatile("" ::: "memory");
        if (tid < 256) { const float t_ = (P[tid * 4 + 0] + P[tid * 4 + 1]) + (P[tid * 4 + 2] + P[tid * 4 + 3]);
            __hip_atomic_store(xbuf + ((size_t)u.pm * BM + tid) * 4 + u.pn, t_, __ATOMIC_RELAXED, __HIP_MEMORY_SCOPE_AGENT); }
        asm volatile("s_waitcnt vmcnt(0)" ::: "memory"); __builtin_amdgcn_s_barrier(); asm volatile("" ::: "memory");
        if (tid == 0) { __hip_atomic_fetch_add(cnt + u.pm, 1u, __ATOMIC_RELAXED, __HIP_MEMORY_SCOPE_AGENT);
            unsigned sp = 0; while (__hip_atomic_load(cnt + u.pm, __ATOMIC_RELAXED, __HIP_MEMORY_SCOPE_AGENT) < 4u) { __builtin_amdgcn_s_sleep(1); if (++sp > (1u << 24)) break; }
            __builtin_amdgcn_fence(__ATOMIC_ACQUIRE, "agent"); asm volatile("s_waitcnt vmcnt(0)" ::: "memory"); }
        __builtin_amdgcn_s_barrier(); asm volatile("" ::: "memory");
        if (tid < 256) { const float* sl = xbuf + ((size_t)u.pm * BM + tid) * 4; float t_ = 0.f;
#pragma unroll
            for (int k = 0; k < 4; ++k) t_ += __hip_atomic_load(sl + k, __ATOMIC_RELAXED, __HIP_MEMORY_SCOPE_AGENT);
            S[tid] = 1.0f / sqrtf(t_ * (1.0f / DM) + RMS_EPS); }
        asm volatile("s_waitcnt lgkmcnt(0)" ::: "memory"); __builtin_amdgcn_s_barrier(); asm volatile("" ::: "memory");
#pragma unroll
        for (int bj = 0; bj < 2; ++bj) { const int c = col0 + bj * HALF;
            const f32x4 g0 = *(const f32x4*)(g + c), g1 = *(const f32x4*)(g + c + 4);
            f32x4 sc0 = {0.f, 0.f, 0.f, 0.f}, sc1 = sc0, sh0 = sc0, sh1 = sc0;
            if (MODE == 0) { sc0 = *(const f32x4*)(scale + (size_t)cls * MODLD + c) + 1.0f; sc1 = *(const f32x4*)(scale + (size_t)cls * MODLD + c + 4) + 1.0f;
                sh0 = *(const f32x4*)(shift + (size_t)cls * MODLD + c); sh1 = *(const f32x4*)(shift + (size_t)cls * MODLD + c + 4); }
#pragma unroll
            for (int ai = 0; ai < 2; ++ai)
#pragma unroll
                for (int m = 0; m < 4; ++m) { const int r = ai * HALF + wr * 64 + m * 16 + fr; const size_t off = (size_t)r * DM + c; const float rs = S[r];
                    const f32x4 x0 = acc[ai][bj][m][0], x1 = acc[ai][bj][m][1]; const f32x4 y0 = x0 * rs * g0, y1 = x1 * rs * g1;
                    if (MODE == 0) { { u32x4 wx; wx.x = cvt_pk_bf16(x0[0], x0[1]); wx.y = cvt_pk_bf16(x0[2], x0[3]); wx.z = cvt_pk_bf16(x1[0], x1[1]); wx.w = cvt_pk_bf16(x1[2], x1[3]); *(u32x4*)(xb_ + off) = wx; }
                        const f32x4 z0 = y0 * sc0 + sh0, z1 = y1 * sc1 + sh1;
                        u32x4 w; w.x = cvt_pk_bf16(z0[0], z0[1]); w.y = cvt_pk_bf16(z0[2], z0[3]); w.z = cvt_pk_bf16(z1[0], z1[1]); w.w = cvt_pk_bf16(z1[2], z1[3]);
                        *(u32x4*)(XN + (size_t)u.pm * BM * DM + off) = w; }
                    else { *(f32x4*)(out_ + off) = y0; *(f32x4*)(out_ + off + 4) = y1; } }
            asm volatile("" ::: "memory"); }
        asm volatile("s_waitcnt lgkmcnt(0)" ::: "memory"); __builtin_amdgcn_s_barrier(); asm volatile("" ::: "memory");
    }
};
struct EpiInProj {
    static constexpr bool PERM = true, AFTER_DRAIN = false;
    bf16_t* Q; bf16_t* Kb; bf16_t* VT; bf16_t* DFTB; const float* ropec; const float* ropes; unsigned* nmax;
    __device__ __forceinline__ void operator()(const f32x4 (&acc)[2][2][4][2], const Unit& u, int wr, int wc, int fr, int fq) const {
        if (u.kind <= 1) {
            bf16_t* dst = u.kind == 0 ? Q : Kb; const float sc = u.kind == 0 ? QSCALE : 1.0f;
            const int axis = wc & 1, pb = 8 * (fq & 1); const bool upper = fq >= 2; float gmax = 0.f;
#pragma unroll
            for (int ai = 0; ai < 2; ++ai)
#pragma unroll
                for (int m = 0; m < 4; ++m) {
                    const int row = u.pm * BM + ai * HALF + wr * 64 + m * 16 + fr;
                    const bool lat = row < MLAT; const int t = row & (SEQ - 1); const int pos = axis ? (t & 63) : (t >> 6);
                    f32x4 c0 = *(const f32x4*)(ropec + pos * 16 + pb), c1 = *(const f32x4*)(ropec + pos * 16 + pb + 4), s0 = *(const f32x4*)(ropes + pos * 16 + pb), s1 = *(const f32x4*)(ropes + pos * 16 + pb + 4);
                    if (!lat) { c0 = (f32x4){1.f, 1.f, 1.f, 1.f}; c1 = c0; s0 = (f32x4){0.f, 0.f, 0.f, 0.f}; s1 = s0; }
                    if (!upper) { s0 = -s0; s1 = -s1; }
                    bf16_t* rowp = dst + (size_t)row * DQK + u.pn * BM + wc * 32 + 8 * fq;
#pragma unroll
                    for (int bj = 0; bj < 2; ++bj) { const f32x4 a0 = acc[ai][bj][m][0], a1 = acc[ai][bj][m][1]; f32x4 p0, p1;
#pragma unroll
                        for (int i = 0; i < 4; ++i) {
                            auto r0 = __builtin_amdgcn_permlane32_swap(__float_as_uint(a0[i]), __float_as_uint(a0[i]), false, false); p0[i] = __uint_as_float(upper ? r0[0] : r0[1]);
                            auto r1 = __builtin_amdgcn_permlane32_swap(__float_as_uint(a1[i]), __float_as_uint(a1[i]), false, false); p1[i] = __uint_as_float(upper ? r1[0] : r1[1]); }
                        const f32x4 o0 = (a0 * c0 + p0 * s0) * sc, o1 = (a1 * c1 + p1 * s1) * sc;
                        { float ss = ((o0[0] * o0[0] + o0[1] * o0[1]) + (o0[2] * o0[2] + o0[3] * o0[3])) + ((o1[0] * o1[0] + o1[1] * o1[1]) + (o1[2] * o1[2] + o1[3] * o1[3]));
                          ss += __shfl_xor(ss, 16); ss += __shfl_xor(ss, 32); gmax = fmaxf(gmax, ss); }
                        u32x4 w; w.x = cvt_pk_bf16(o0[0], o0[1]); w.y = cvt_pk_bf16(o0[2], o0[3]); w.z = cvt_pk_bf16(o1[0], o1[1]); w.w = cvt_pk_bf16(o1[2], o1[3]);
                        *(u32x4*)(rowp + bj * HALF) = w; }
                }
#pragma unroll
            for (int o = 1; o < 16; o <<= 1) gmax = fmaxf(gmax, __shfl_xor(gmax, o));
            if ((fr | fq) == 0) atomicMax(nmax + u.kind * 64 + ((u.pm * 8 + wr * 4 + wc) & 63), __float_as_uint(gmax));
        } else {
            bf16_t* base; size_t ld;
            if (u.kind == 2) { base = VT + (size_t)u.pm * BM * MALL + (size_t)u.pn * BM; ld = MALL; }
            else {
                const int b = u.pn >> 4, j = u.pn & 15; base = DFTB + ((size_t)(b * 256) * 64 + 4 * j) * 128 + (size_t)u.pm * 64; ld = 64 * 128; }
#pragma unroll
            for (int ai = 0; ai < 2; ++ai)
#pragma unroll
                for (int m = 0; m < 4; ++m) { bf16_t* rowp = base + (size_t)(ai * HALF + wr * 64 + m * 16 + fr) * ld + (u.kind == 2 ? wc * 32 : (wc >> 1) * 128 + (wc & 1) * 32) + 8 * fq;
#pragma unroll
                    for (int bj = 0; bj < 2; ++bj) { const f32x4 v0 = acc[ai][bj][m][0], v1 = acc[ai][bj][m][1];
                        u32x4 w; w.x = cvt_pk_bf16(v0[0], v0[1]); w.y = cvt_pk_bf16(v0[2], v0[3]); w.z = cvt_pk_bf16(v1[0], v1[1]); w.w = cvt_pk_bf16(v1[2], v1[3]);
                        *(u32x4*)(rowp + (u.kind == 2 ? bj * HALF : bj * 256)) = w; } }
        }
    }
};
struct EpiFFT1 {
    static constexpr bool PERM = true, AFTER_DRAIN = false;
    bf16_t* YT; const f32x2* TW;
    __device__ __forceinline__ void operator()(const f32x4 (&acc)[2][2][4][2], const Unit& u, int wr, int wc, int fr, int fq) const {
        if (wr != 0) return;
        const __amdgpu_buffer_rsrc_t rsrc = __builtin_amdgcn_make_buffer_rsrc(YT, 0, 65536 * 128 * 2, 0x00020000);
#pragma unroll
        for (int m = 0; m < 4; ++m) { const int k1 = 16 * m + fr;
#pragma unroll
            for (int bj = 0; bj < 2; ++bj) { const int col = 4 * u.pn + 2 * bj + (wc >> 1), b = col >> 8, ch = col & 255;
                const int n2 = 32 * (wc & 1) + 8 * fq;
                const unsigned rowo = (unsigned)((((size_t)(b * 64 + k1) * 256 + ch) * 128 + n2) * 2);
                int kk = k1; asm volatile("" : "+v"(kk));
                f32x4 pr[2], pi[2];
#pragma unroll
                for (int n = 0; n < 2; ++n) { const f32x4 yr = acc[0][bj][m][n], yi = acc[1][bj][m][n];
#pragma unroll
                    for (int i = 0; i < 4; ++i) { const f32x2 cs = TW[(n2 + 4 * n + i) * kk]; pr[n][i] = yr[i] * cs.x + yi[i] * cs.y; pi[n][i] = yi[i] * cs.x - yr[i] * cs.y; } }
                u32x4 w; w.x = cvt_pk_bf16(pr[0][0], pr[0][1]); w.y = cvt_pk_bf16(pr[0][2], pr[0][3]); w.z = cvt_pk_bf16(pr[1][0], pr[1][1]); w.w = cvt_pk_bf16(pr[1][2], pr[1][3]);
                __builtin_amdgcn_raw_buffer_store_b128(w, rsrc, rowo, 0, 16);
                w.x = cvt_pk_bf16(pi[0][0], pi[0][1]); w.y = cvt_pk_bf16(pi[0][2], pi[0][3]); w.z = cvt_pk_bf16(pi[1][0], pi[1][1]); w.w = cvt_pk_bf16(pi[1][2], pi[1][3]);
                __builtin_amdgcn_raw_buffer_store_b128(w, rsrc, rowo + 128, 0, 16);
                asm volatile("" ::: "memory"); } }
    }
};
struct EpiFFT2 {
    static constexpr bool PERM = true, AFTER_DRAIN = false;
    bf16_t* AO;
    __device__ __forceinline__ void operator()(const f32x4 (&acc)[2][2][4][2], const Unit& u, int wr, int wc, int fr, int fq) const {
        if (wr != 0) return;
        const float sc = 1.0f / 512.0f; const int b = u.pn >> 6, k1 = u.pn & 63;
#pragma unroll
        for (int m = 0; m < 4; ++m) { const int k2 = 16 * m + fr; bf16_t* rowp = AO + (size_t)(b * SEQ + 64 * k2 + k1) * DM + DQK + wc * 32 + 8 * fq;
#pragma unroll
            for (int bj = 0; bj < 2; ++bj) { const f32x4 v0 = acc[0][bj][m][0] * sc, v1 = acc[0][bj][m][1] * sc;
                u32x4 w; w.x = cvt_pk_bf16(v0[0], v0[1]); w.y = cvt_pk_bf16(v0[2], v0[3]); w.z = cvt_pk_bf16(v1[0], v1[1]); w.w = cvt_pk_bf16(v1[2], v1[3]);
                *(u32x4*)(rowp + bj * HALF) = w; } }
    }
};
}

struct Args { const float* in[24]; float* out; unsigned char* ws; int ph_lo, ph_hi; };
enum { I_X = 0, I_C, I_CTX, I_CCTX, I_WADA, I_BADA, I_N1G, I_F1G, I_F1U, I_F1D, I_NMG, I_WIN, I_LQ1, I_LK1, I_LQ2, I_LK2, I_SUBG, I_WFOUR, I_WOUT, I_N2G, I_F2G, I_F2U, I_F2D, I_FNG };

__device__ __forceinline__ void wg_publish(unsigned* cnt);
__device__ __forceinline__ void wg_await(unsigned* cnt, unsigned want);
__device__ __forceinline__ unsigned f2bf(float f) { unsigned u = __builtin_bit_cast(unsigned, f); return (u + 0x7fffu + ((u >> 16) & 1u)) >> 16; }
__device__ __forceinline__ unsigned pk2(float lo, float hi) { return f2bf(lo) | (f2bf(hi) << 16); }

__device__ __forceinline__ void transpose_item(const float* W, int ldw, int k0, int nsrc0, bf16_t* WT, int ldt, int drow0, int dk0, LAS float* scr, int lane) {
#pragma unroll
    for (int i = 0; i < 8; ++i) { const int kk = 8 * i + (lane >> 3), c4 = lane & 7; const f32x4 v = *(const f32x4*)(W + (size_t)(k0 + kk) * ldw + nsrc0 + 4 * c4);
        scr[kk * 33 + 4 * c4] = v[0]; scr[kk * 33 + 4 * c4 + 1] = v[1]; scr[kk * 33 + 4 * c4 + 2] = v[2]; scr[kk * 33 + 4 * c4 + 3] = v[3]; }
    asm volatile("s_waitcnt lgkmcnt(0)" ::: "memory");
    const int c = lane & 7;
#pragma unroll
    for (int j = 0; j < 4; ++j) { const int n = (lane >> 3) + 8 * j; const LAS float* s = scr + (8 * c) * 33 + n;
        u32x4 o; o.x = pk2(s[0 * 33], s[1 * 33]); o.y = pk2(s[2 * 33], s[3 * 33]); o.z = pk2(s[4 * 33], s[5 * 33]); o.w = pk2(s[6 * 33], s[7 * 33]);
        *(u32x4*)(WT + (size_t)(drow0 + n) * ldt + dk0 + k0 + 8 * c) = o; }
    asm volatile("s_waitcnt lgkmcnt(0)" ::: "memory");
}

__device__ __forceinline__ void weight_transposes(const Args& A, LAS unsigned char* lds, int wk, int nwk, const int tid, const int stage) {
    const int lane = tid & 63, wave = __builtin_amdgcn_readfirstlane(tid >> 6);
    unsigned char* ws = A.ws;
    LAS float* scr = (LAS float*)(lds + wave * 16384);
    const int gw = wk * 8 + wave, NGW = nwk * 8;
    constexpr int I_GU = 16 * 88, I_DN = 44 * 32, I_IN = 16 * 72, I_OUT = 12 * 32;
    const bool ffn2 = stage >= 2;
    const int n_gu = (stage == 0 || stage == 2) ? 2 * I_GU : 0, n_dn = (stage == 1 || stage == 3) ? I_DN : 0, n_x = stage == 1 ? I_IN : (stage == 4 ? I_OUT : 0);
    const int nit = n_gu + n_dn + n_x;
    for (int it = gw; it < nit; it += NGW) {
        int r = it;
        if (r < n_gu) {
            const int up = r / I_GU; r -= up * I_GU; const int kb = r / 88, nb = r % 88, n0 = nb * 32;
            const float* W = A.in[ffn2 ? (up ? I_F2U : I_F2G) : (up ? I_F1U : I_F1G)];
            bf16_t* WT = (bf16_t*)(ws + (ffn2 ? WS_WGU2 : WS_WGU1));
            transpose_item(W, DFF, kb * 64, n0, WT, DM, 256 * (n0 >> 7) + (n0 & 127) + (up ? 128 : 0), 0, scr, lane);
            continue;
        }
        r -= n_gu;
        if (r < n_dn) {
            const int kb = r / 32, nb = r % 32;
            transpose_item(A.in[ffn2 ? I_F2D : I_F1D], DM, kb * 64, nb * 32, (bf16_t*)(ws + (ffn2 ? WS_WD2 : WS_WD1)), DFF, nb * 32, 0, scr, lane);
            continue;
        }
        r -= n_dn;
        if (!ffn2) { const int kb = r / 72, nb = r % 72; transpose_item(A.in[I_WIN], 2560, kb * 64, nb * 32, (bf16_t*)(ws + WS_WIN), DM, nb * 32, 0, scr, lane); }
        else { const int kb = r / 32, nb = r % 32; transpose_item(A.in[I_WOUT], DM, kb * 64, nb * 32, (bf16_t*)(ws + WS_WO), DM, nb * 32, 0, scr, lane); }
    }
}

__device__ __forceinline__ void prologue(const Args& A, LAS unsigned char* lds, int vcu, int G, const int tid) {
    const int lane = tid & 63, wave = __builtin_amdgcn_readfirstlane(tid >> 6);
    unsigned char* ws = A.ws;
    const int vf = vcu - (G - 3);
    if (vf == 0 || vf == 1) {
        bf16_t* Mx = (bf16_t*)(ws + (vf == 0 ? WS_M1 : WS_M2));
        for (int i = tid; i < 256 * 128; i += 512) { const int r = i >> 7, kap = i & 127, part = kap >> 6, nn = kap & 63; float v = 0.f;
            if (vf == 0) { if (r < 64) { const float ph = (float)((r * nn) & 63) * (1.0f / 32.0f); v = part == 0 ? cospif(ph) : -sinpif(ph); }
                            else if (r >= 128 && r < 192) { const float ph = (float)(((r - 128) * nn) & 63) * (1.0f / 32.0f); v = part == 0 ? -sinpif(ph) : -cospif(ph); } }
            else { if (r < 64) { const float ph = (float)((r * nn) & 63) * (1.0f / 32.0f); v = part == 0 ? cospif(ph) : sinpif(ph); } }
            Mx[i] = (bf16_t)f2bf(v); }
    } else if (vf == 2) {
        f32x2* TW = (f32x2*)(ws + WS_TW);
        for (int i = tid; i < 4096; i += 512) { const float ph = (float)i * (1.0f / 2048.0f); TW[i] = (f32x2){cospif(ph), sinpif(ph)}; }
    }
    for (int it = vcu; it < 257; it += G) {
        if (it < 128) {
            LAS float* sc = (LAS float*)lds;
            LAS float* red = (LAS float*)(lds + 5 * 1024 * 4);
            for (int i = tid; i < 5 * 1024; i += 512) { const int r = i >> 10, k = i & 1023; const float cv = r < 4 ? A.in[I_C][r * 1024 + k] : A.in[I_CCTX][k]; sc[i] = cv / (1.0f + expf(-cv)); }
            __syncthreads();
            const int n0 = it * 72, c4 = tid % 18, kg = tid / 18;
            f32x4 a0 = {0.f, 0.f, 0.f, 0.f}, a1 = a0, a2 = a0, a3 = a0, a4 = a0;
            if (kg < 28) {
                const float* wp = A.in[I_WADA] + n0 + 4 * c4;
#pragma unroll 8
                for (int kk = 0; kk < 37; ++kk) { const int k = kg + 28 * kk; if (k < 1024) { const f32x4 w = *(const f32x4*)(wp + (size_t)k * MODLD);
                    a0 += w * sc[k]; a1 += w * sc[1024 + k]; a2 += w * sc[2048 + k]; a3 += w * sc[3072 + k]; a4 += w * sc[4096 + k]; } }
                *(LAS f32x4*)(red + (0 * 28 + kg) * 72 + 4 * c4) = a0; *(LAS f32x4*)(red + (1 * 28 + kg) * 72 + 4 * c4) = a1; *(LAS f32x4*)(red + (2 * 28 + kg) * 72 + 4 * c4) = a2;
                *(LAS f32x4*)(red + (3 * 28 + kg) * 72 + 4 * c4) = a3; *(LAS f32x4*)(red + (4 * 28 + kg) * 72 + 4 * c4) = a4; }
            __syncthreads();
            if (tid < 360) { const int r = tid / 72, n = tid % 72; float s_ = A.in[I_BADA][n0 + n];
                for (int q = 0; q < 28; ++q) s_ += red[(r * 28 + q) * 72 + n];
                __hip_atomic_store((float*)(ws + WS_MOD) + r * MODLD + n0 + n, s_, __ATOMIC_RELAXED, __HIP_MEMORY_SCOPE_AGENT); }
            wg_publish((unsigned*)(ws + WS_BAR) + 3856);
            __syncthreads();
        } else if (it < 192) {
            const int item = it - 128, k0 = (item >> 2) * 64, g = item & 3;
            LAS float* wt = (LAS float*)lds;
            LAS float* tab = (LAS float*)(lds + 64 * 65 * 4);
            for (int i = tid; i < 4096; i += 512) { const int kk = i >> 6, d = i & 63; wt[kk * 65 + d] = A.in[I_WIN][(size_t)(k0 + kk) * 2560 + 2304 + g * 64 + d]; }
            if (tid < 64) tab[tid] = cospif((float)tid * (1.0f / 32.0f));
            __syncthreads();
            const int kk = tid & 63, grp = tid >> 6;
            bf16_t* WF = (bf16_t*)(ws + WS_WF);
            for (int jj = 0; jj < 16; ++jj) {
                const int e = grp * 16 + jj, part = e >> 6, dp = e & 63, add = part ? 48 : 0;
                float s_ = 0.f;
#pragma unroll 8
                for (int d = 0; d < 64; ++d) s_ += wt[kk * 65 + d] * tab[(d * dp + add) & 63];
                WF[(size_t)(part * 256 + g * 64 + dp) * DM + k0 + kk] = (bf16_t)f2bf(s_);
            }
            __syncthreads();
        } else if (it < 256) {
            const int item = it - 192, n0 = (item >> 2) * 64, j0 = (item & 3) * 64;
            LAS float* wo = (LAS float*)lds;
            LAS float* wfl = (LAS float*)(lds + 65536);
            for (int i = tid; i < 256 * 64; i += 512) { const int ii = i >> 6, n = i & 63; wo[i] = A.in[I_WOUT][(size_t)(768 + ii) * DM + n0 + n]; }
            for (int i = tid; i < 64 * 256; i += 512) wfl[i] = A.in[I_WFOUR][(size_t)j0 * 256 + i];
            __syncthreads();
            bf16_t* WO = (bf16_t*)(ws + WS_WO);
            float acc[8];
#pragma unroll
            for (int q = 0; q < 8; ++q) acc[q] = 0.f;
#pragma unroll 4
            for (int i = 0; i < 256; ++i) { const float w = wo[i * 64 + lane];
#pragma unroll
                for (int q = 0; q < 8; ++q) acc[q] += wfl[(wave * 8 + q) * 256 + i] * w; }
#pragma unroll
            for (int q = 0; q < 8; ++q) WO[(size_t)(n0 + lane) * DM + 768 + j0 + wave * 8 + q] = (bf16_t)f2bf(acc[q]);
            __syncthreads();
        } else {
            float* rc = (float*)(ws + WS_ROPE); float* rs = rc + 1024;
            for (int i = tid; i < 1024; i += 512) { const int pos = i >> 4, p = i & 15; const float inv = powf(10000.0f, -(float)p / 16.0f); const float ang = (float)pos * inv; rc[i] = cosf(ang); rs[i] = sinf(ang); }
            if (wave == 0) {
                const float d1 = wave_sum(A.in[I_LQ1][lane] * A.in[I_LK1][lane]), d2 = wave_sum(A.in[I_LQ2][lane] * A.in[I_LK2][lane]);
                if (lane == 0) ((float*)(ws + WS_SCAL))[0] = expf(d1) - expf(d2) + LAMBDA_INIT;
            }
        }
    }
    __syncthreads();
    weight_transposes(A, lds, vcu, G, tid, 0);
}

template <bool MOD>
__device__ __forceinline__ void rownorm1(const float* xrow, const bf16_t* part, const float* g, const float* shift, const float* scale, bf16_t* obf, float* of32, int lane) {
    f32x4 v[4]; float ss = 0.f;
#pragma unroll
    for (int j = 0; j < 4; ++j) { v[j] = ((const f32x4*)xrow)[lane + 64 * j]; if (part) {
            for (int ks = 0; ks < 11; ++ks) { const u32x2 w = ((const u32x2*)(part + (size_t)ks * MCTX * DM))[lane + 64 * j];
                v[j][0] += __uint_as_float(w.x << 16); v[j][1] += __uint_as_float(w.x & 0xffff0000u); v[j][2] += __uint_as_float(w.y << 16); v[j][3] += __uint_as_float(w.y & 0xffff0000u); } }
        ss += (v[j][0] * v[j][0] + v[j][1] * v[j][1]) + (v[j][2] * v[j][2] + v[j][3] * v[j][3]); }
    const float rstd = 1.0f / sqrtf(wave_sum(ss) * (1.0f / DM) + RMS_EPS);
#pragma unroll
    for (int j = 0; j < 4; ++j) {
        const f32x4 gv = ((const f32x4*)g)[lane + 64 * j];
        f32x4 y = v[j] * rstd * gv;
        if (MOD) { const f32x4 sh = ((const f32x4*)shift)[lane + 64 * j], sc = ((const f32x4*)scale)[lane + 64 * j]; y = y * (sc + 1.0f) + sh;
            u32x2 w; w.x = cvt_pk_bf16(y[0], y[1]); w.y = cvt_pk_bf16(y[2], y[3]); ((u32x2*)obf)[lane + 64 * j] = w; }
        else ((f32x4*)of32)[lane + 64 * j] = y;
    }
}

template <bool MOD>
__device__ __forceinline__ void rownorm2(const float* xa, const float* xb, const float* g, const float* sha, const float* sca, const float* shb, const float* scb, bf16_t* oa, bf16_t* ob, float* fa, float* fb, int lane) {
    f32x4 va[4], vb[4]; float sa = 0.f, sb = 0.f;
#pragma unroll
    for (int j = 0; j < 4; ++j) { const int ix = 128 * (j >> 1) + 2 * lane + (j & 1); va[j] = ((const f32x4*)xa)[ix]; vb[j] = ((const f32x4*)xb)[ix]; }
#pragma unroll
    for (int j = 0; j < 4; ++j) { sa += (va[j][0] * va[j][0] + va[j][1] * va[j][1]) + (va[j][2] * va[j][2] + va[j][3] * va[j][3]); sb += (vb[j][0] * vb[j][0] + vb[j][1] * vb[j][1]) + (vb[j][2] * vb[j][2] + vb[j][3] * vb[j][3]); }
#pragma unroll
    for (int o = 1; o < 64; o <<= 1) { sa += __shfl_xor(sa, o); sb += __shfl_xor(sb, o); }
    const float ra = 1.0f / sqrtf(sa * (1.0f / DM) + RMS_EPS), rb = 1.0f / sqrtf(sb * (1.0f / DM) + RMS_EPS);
#pragma unroll
    for (int j2 = 0; j2 < 2; ++j2) {
        f32x4 ya[2], yb[2];
#pragma unroll
        for (int h = 0; h < 2; ++h) { const int ix = 128 * j2 + 2 * lane + h; const f32x4 gv = ((const f32x4*)g)[ix];
            ya[h] = va[2 * j2 + h] * ra * gv; yb[h] = vb[2 * j2 + h] * rb * gv;
            if (MOD) { ya[h] = ya[h] * (((const f32x4*)sca)[ix] + 1.0f) + ((const f32x4*)sha)[ix]; yb[h] = yb[h] * (((const f32x4*)scb)[ix] + 1.0f) + ((const f32x4*)shb)[ix]; }
            else { ((f32x4*)fa)[ix] = ya[h]; ((f32x4*)fb)[ix] = yb[h]; } }
        if (MOD) { u32x4 w; w.x = cvt_pk_bf16(ya[0][0], ya[0][1]); w.y = cvt_pk_bf16(ya[0][2], ya[0][3]); w.z = cvt_pk_bf16(ya[1][0], ya[1][1]); w.w = cvt_pk_bf16(ya[1][2], ya[1][3]); ((u32x4*)oa)[64 * j2 + lane] = w;
            w.x = cvt_pk_bf16(yb[0][0], yb[0][1]); w.y = cvt_pk_bf16(yb[0][2], yb[0][3]); w.z = cvt_pk_bf16(yb[1][0], yb[1][1]); w.w = cvt_pk_bf16(yb[1][2], yb[1][3]); ((u32x4*)ob)[64 * j2 + lane] = w; }
    }
}

constexpr int AT_KSLOT = 16384, AT_VSLOT = 16384, AT_VBASE = 3 * AT_KSLOT;
__device__ __forceinline__ int at_tok0(int b, int t) { return t < 64 ? b * SEQ + 64 * t : MLAT + b * CTXL + 64 * (t - 64); }
__device__ __forceinline__ float max3f(float a, float b, float c) { float r; asm("v_max3_f32 %0, %1, %2, %3" : "=v"(r) : "v"(a), "v"(b), "v"(c)); return r; }
__device__ __forceinline__ float xhalf_max(float v) { auto rr = __builtin_amdgcn_permlane32_swap(__float_as_uint(v), __float_as_uint(v), false, false); return max3f(__uint_as_float(rr[0]), __uint_as_float(rr[1]), v); }
__device__ __forceinline__ float xhalf_sum(float v) { auto rr = __builtin_amdgcn_permlane32_swap(__float_as_uint(v), __float_as_uint(v), false, false); return __uint_as_float(rr[0]) + __uint_as_float(rr[1]); }

__device__ __forceinline__ void attn_phase(const Args& A, LAS unsigned char* lds, int vcu, int G, const int tid) {
    const int lane = tid & 63, r32 = lane & 31, hi = lane >> 5, wid = __builtin_amdgcn_readfirstlane(tid >> 6), qi = wid & 3, c = wid >> 2;
    const bf16_t* Q = (const bf16_t*)(A.ws + WS_Q); const char* Kg = (const char*)(A.ws + WS_K); const char* VT = (const char*)(A.ws + WS_VT);
    bf16_t* AO = (bf16_t*)(A.ws + WS_AO);
    const float lam = ((const float*)(A.ws + WS_SCAL))[0];
    constexpr int NT = 68;
    bool fast; { const unsigned* nm = (const unsigned*)(A.ws + WS_BAR) + 3456; unsigned mq = nm[lane], mk = nm[64 + lane];
#pragma unroll
        for (int o_ = 1; o_ < 64; o_ <<= 1) { const unsigned a_ = __shfl_xor(mq, o_), b_ = __shfl_xor(mk, o_); mq = a_ > mq ? a_ : mq; mk = b_ > mk ? b_ : mk; }
        const float qn = sqrtf(__uint_as_float(mq)), kn = sqrtf(__uint_as_float(mk));
        fast = __builtin_amdgcn_readfirstlane((int)(2.0f * qn * kn * 1.03f < 96.0f)) != 0; }
    unsigned kso[2], vso[2];
#pragma unroll
    for (int i = 0; i < 2; ++i) {
        const int p = 2 * wid + i;
        { const int row = 4 * p + (lane >> 4), cp = lane & 15, cg_ = cp ^ (row & 15); kso[i] = (unsigned)(row * (DQK * 2) + cg_ * 16); }
        { const int row = 8 * p + (lane >> 3), cp = lane & 7, cg_ = cp ^ ((row >> 1) & 7); vso[i] = (unsigned)(row * (MALL * 2) + cg_ * 16); }
    }
    const int pi_r = (r32 & 0x13) | ((r32 & 4) << 1) | ((r32 & 8) >> 1);
    const int kad0 = pi_r * 256 + (((8 * c + hi) ^ (pi_r & 15)) * 16), vad0 = r32 * 128 + ((hi ^ ((r32 >> 1) & 7)) * 16);
#define AT_DMAK(t_, slot_) do { const char* kb_ = Kg + (size_t)at_tok0(b, (t_)) * (DQK * 2) + h * 256; LAS unsigned char* sl_ = lds + (slot_) * AT_KSLOT; \
        __builtin_amdgcn_global_load_lds((const unsigned*)(kb_ + kso[0]), (LAS unsigned*)(sl_ + (2 * wid) * 1024), 16, 0, 0); \
        __builtin_amdgcn_global_load_lds((const unsigned*)(kb_ + kso[1]), (LAS unsigned*)(sl_ + (2 * wid + 1) * 1024), 16, 0, 0); } while (0)
#define AT_DMAV(t_, slot_) do { const char* vb_ = VT + (size_t)(h * 128) * (MALL * 2) + (size_t)at_tok0(b, (t_)) * 2; LAS unsigned char* sl_ = lds + AT_VBASE + (slot_) * AT_VSLOT; \
        __builtin_amdgcn_global_load_lds((const unsigned*)(vb_ + vso[0]), (LAS unsigned*)(sl_ + (2 * wid) * 1024), 16, 0, 0); \
        __builtin_amdgcn_global_load_lds((const unsigned*)(vb_ + vso[1]), (LAS unsigned*)(sl_ + (2 * wid + 1) * 1024), 16, 0, 0); } while (0)
#define SBAR() do {} while (0)
#define EXG(S, e, F) do { f32x4 x_ = (f32x4){S[4 * (e)], S[4 * (e) + 1], S[4 * (e) + 2], S[4 * (e) + 3]}; if (!(F)) x_ = x_ - mrow; \
        S[4 * (e)] = __builtin_amdgcn_exp2f(x_[0]); S[4 * (e) + 1] = __builtin_amdgcn_exp2f(x_[1]); S[4 * (e) + 2] = __builtin_amdgcn_exp2f(x_[2]); S[4 * (e) + 3] = __builtin_amdgcn_exp2f(x_[3]); } while (0)
#define KFR(g) (*(const LAS bf16x8*)(bufK + (kadl ^ (((g) >> 1) * 32)) + ((g) & 1) * 32 * 256))
#define VFR(g) (*(const LAS bf16x8*)(bufV + (vadl ^ (((g) >> 2) * 32)) + ((g) & 3) * 32 * 128))
#define PACK(S, q) ({ u32x4 w_; w_.x = cvt_pk_bf16(S[8 * (q)], S[8 * (q) + 1]); w_.y = cvt_pk_bf16(S[8 * (q) + 2], S[8 * (q) + 3]); w_.z = cvt_pk_bf16(S[8 * (q) + 4], S[8 * (q) + 5]); w_.w = cvt_pk_bf16(S[8 * (q) + 6], S[8 * (q) + 7]); __builtin_bit_cast(bf16x8, w_); })
#define SUM4(S, e) do { ps[0] += S[4 * (e)]; ps[1] += S[4 * (e) + 1]; ps[2] += S[4 * (e) + 2]; ps[3] += S[4 * (e) + 3]; asm volatile("" : "+v"(ps)); } while (0)
#define AT_STEP_A(C0, C1, N0, N1, t_, FAST_) do { \
            if ((t_) + 3 < NT) AT_DMAK((t_) + 3, k0s); if ((t_) + 2 < NT) AT_DMAV((t_) + 2, ((t_) + 2) & 3); \
            const LAS unsigned char* bufK = lds + (k0s == 2 ? 0 : k0s + 1) * AT_KSLOT; int kadl = kad0, vadl = vad0; asm volatile("" : "+v"(kadl), "+v"(vadl)); \
            const LAS unsigned char* bufV = lds + AT_VBASE + ((t_) & 3) * AT_VSLOT; \
            bf16x8 f0 = KFR(0), f1 = KFR(1), f2 = KFR(2), f3 = KFR(3); \
            if (!(FAST_)) { float ma = max3f(C0[0], C0[1], C1[0]), mb = max3f(C0[2], C0[3], C1[1]); ma = max3f(ma, C1[2], C1[3]); \
            _Pragma("unroll") for (int r = 4; r < 16; r += 4) { ma = max3f(ma, C0[r], C0[r + 1]); mb = max3f(mb, C0[r + 2], C0[r + 3]); ma = max3f(ma, C1[r], C1[r + 1]); mb = max3f(mb, C1[r + 2], C1[r + 3]); } \
            const float mx = xhalf_max(max3f(ma, mb, mb)); \
            if (__any(mx > mrow)) { const float mn = max3f(mrow, mx, mx), al = __builtin_amdgcn_exp2f(mrow - mn); lrow *= al; mrow = mn; \
                _Pragma("unroll") for (int i = 0; i < 4; ++i) _Pragma("unroll") for (int r = 0; r < 16; ++r) o[i][r] *= al; } } \
            N0 = f32x16{}; N1 = f32x16{}; \
            N0 = __builtin_amdgcn_mfma_f32_32x32x16_bf16(f0, qf[0], N0, 0, 0, 0); f0 = KFR(4); EXG(C0, 0, FAST_); SBAR(); \
            N1 = __builtin_amdgcn_mfma_f32_32x32x16_bf16(f1, qf[0], N1, 0, 0, 0); f1 = KFR(5); EXG(C0, 1, FAST_); SBAR(); \
            N0 = __builtin_amdgcn_mfma_f32_32x32x16_bf16(f2, qf[1], N0, 0, 0, 0); f2 = KFR(6); EXG(C0, 2, FAST_); SBAR(); \
            N1 = __builtin_amdgcn_mfma_f32_32x32x16_bf16(f3, qf[1], N1, 0, 0, 0); f3 = KFR(7); EXG(C0, 3, FAST_); SBAR(); \
            N0 = __builtin_amdgcn_mfma_f32_32x32x16_bf16(f0, qf[2], N0, 0, 0, 0); f0 = VFR(0); EXG(C1, 0, FAST_); SBAR(); \
            N1 = __builtin_amdgcn_mfma_f32_32x32x16_bf16(f1, qf[2], N1, 0, 0, 0); f1 = VFR(1); EXG(C1, 1, FAST_); SBAR(); \
            N0 = __builtin_amdgcn_mfma_f32_32x32x16_bf16(f2, qf[3], N0, 0, 0, 0); f2 = VFR(2); EXG(C1, 2, FAST_); SBAR(); \
            N1 = __builtin_amdgcn_mfma_f32_32x32x16_bf16(f3, qf[3], N1, 0, 0, 0); f3 = VFR(3); EXG(C1, 3, FAST_); SBAR(); \
            f32x4 ps = (f32x4){0.f, 0.f, 0.f, 0.f}; bf16x8 p0 = PACK(C0, 0), p1, p2, p3; SBAR(); \
            o[0] = __builtin_amdgcn_mfma_f32_32x32x16_bf16(f0, p0, o[0], 0, 0, 0); f0 = VFR(4); p1 = PACK(C0, 1); SBAR(); \
            o[1] = __builtin_amdgcn_mfma_f32_32x32x16_bf16(f1, p0, o[1], 0, 0, 0); f1 = VFR(5); SUM4(C0, 0); SUM4(C0, 1); SBAR(); \
            o[2] = __builtin_amdgcn_mfma_f32_32x32x16_bf16(f2, p0, o[2], 0, 0, 0); f2 = VFR(6); SUM4(C0, 2); SUM4(C0, 3); SBAR(); \
            o[3] = __builtin_amdgcn_mfma_f32_32x32x16_bf16(f3, p0, o[3], 0, 0, 0); f3 = VFR(7);  SBAR(); \
            o[0] = __builtin_amdgcn_mfma_f32_32x32x16_bf16(f0, p1, o[0], 0, 0, 0); f0 = VFR(8); p2 = PACK(C1, 0); SBAR(); \
            o[1] = __builtin_amdgcn_mfma_f32_32x32x16_bf16(f1, p1, o[1], 0, 0, 0); f1 = VFR(9); SUM4(C1, 0); SUM4(C1, 1); SBAR(); \
            o[2] = __builtin_amdgcn_mfma_f32_32x32x16_bf16(f2, p1, o[2], 0, 0, 0); f2 = VFR(10); SUM4(C1, 2); SUM4(C1, 3); SBAR(); \
            o[3] = __builtin_amdgcn_mfma_f32_32x32x16_bf16(f3, p1, o[3], 0, 0, 0); f3 = VFR(11);  SBAR(); \
            o[0] = __builtin_amdgcn_mfma_f32_32x32x16_bf16(f0, p2, o[0], 0, 0, 0); f0 = VFR(12); p3 = PACK(C1, 1); SBAR(); \
            o[1] = __builtin_amdgcn_mfma_f32_32x32x16_bf16(f1, p2, o[1], 0, 0, 0); f1 = VFR(13);  SBAR(); \
            o[2] = __builtin_amdgcn_mfma_f32_32x32x16_bf16(f2, p2, o[2], 0, 0, 0); f2 = VFR(14);  SBAR(); \
            o[3] = __builtin_amdgcn_mfma_f32_32x32x16_bf16(f3, p2, o[3], 0, 0, 0); f3 = VFR(15);  SBAR(); \
            o[0] = __builtin_amdgcn_mfma_f32_32x32x16_bf16(f0, p3, o[0], 0, 0, 0);  SBAR(); \
            o[1] = __builtin_amdgcn_mfma_f32_32x32x16_bf16(f1, p3, o[1], 0, 0, 0);  SBAR(); \
            o[2] = __builtin_amdgcn_mfma_f32_32x32x16_bf16(f2, p3, o[2], 0, 0, 0);  SBAR(); \
            o[3] = __builtin_amdgcn_mfma_f32_32x32x16_bf16(f3, p3, o[3], 0, 0, 0);  SBAR(); \
            lrow += (ps[0] + ps[1]) + (ps[2] + ps[3]); \
            if ((t_) + 3 < NT) asm volatile("s_waitcnt vmcnt(4) lgkmcnt(0)" ::: "memory"); else if ((t_) + 2 < NT) asm volatile("s_waitcnt vmcnt(2) lgkmcnt(0)" ::: "memory"); else asm volatile("s_waitcnt vmcnt(0) lgkmcnt(0)" ::: "memory"); \
            __builtin_amdgcn_s_barrier(); asm volatile("" ::: "memory"); \
            k0s = k0s == 2 ? 0 : k0s + 1; } while (0)
#define AT_STEP_B(C0, C1, N0, N1, t_, FAST_) do { \
            if ((t_) + 3 < NT) AT_DMAK((t_) + 3, k0s); if ((t_) + 2 < NT) AT_DMAV((t_) + 2, ((t_) + 2) & 3); \
            const LAS unsigned char* bufK = lds + (k0s == 2 ? 0 : k0s + 1) * AT_KSLOT; int kadl = kad0, vadl = vad0; asm volatile("" : "+v"(kadl), "+v"(vadl)); \
            const LAS unsigned char* bufV = lds + AT_VBASE + (((t_) - 1) & 3) * AT_VSLOT; \
            bf16x8 f0 = VFR(0), f1 = VFR(1), f2 = VFR(2), f3 = VFR(3); \
            o[0] = __builtin_amdgcn_mfma_f32_32x32x16_bf16(f0, p0, o[0], 0, 0, 0); f0 = VFR(4);  SBAR(); \
            o[1] = __builtin_amdgcn_mfma_f32_32x32x16_bf16(f1, p0, o[1], 0, 0, 0); f1 = VFR(5);  SBAR(); \
            o[2] = __builtin_amdgcn_mfma_f32_32x32x16_bf16(f2, p0, o[2], 0, 0, 0); f2 = VFR(6);  SBAR(); \
            o[3] = __builtin_amdgcn_mfma_f32_32x32x16_bf16(f3, p0, o[3], 0, 0, 0); f3 = VFR(7);  SBAR(); \
            o[0] = __builtin_amdgcn_mfma_f32_32x32x16_bf16(f0, p1, o[0], 0, 0, 0); f0 = VFR(8);  SBAR(); \
            o[1] = __builtin_amdgcn_mfma_f32_32x32x16_bf16(f1, p1, o[1], 0, 0, 0); f1 = VFR(9);  SBAR(); \
            o[2] = __builtin_amdgcn_mfma_f32_32x32x16_bf16(f2, p1, o[2], 0, 0, 0); f2 = VFR(10);  SBAR(); \
            o[3] = __builtin_amdgcn_mfma_f32_32x32x16_bf16(f3, p1, o[3], 0, 0, 0); f3 = VFR(11);  SBAR(); \
            o[0] = __builtin_amdgcn_mfma_f32_32x32x16_bf16(f0, p2, o[0], 0, 0, 0); f0 = VFR(12);  SBAR(); \
            o[1] = __builtin_amdgcn_mfma_f32_32x32x16_bf16(f1, p2, o[1], 0, 0, 0); f1 = VFR(13);  SBAR(); \
            o[2] = __builtin_amdgcn_mfma_f32_32x32x16_bf16(f2, p2, o[2], 0, 0, 0); f2 = VFR(14);  SBAR(); \
            o[3] = __builtin_amdgcn_mfma_f32_32x32x16_bf16(f3, p2, o[3], 0, 0, 0); f3 = VFR(15);  SBAR(); \
            o[0] = __builtin_amdgcn_mfma_f32_32x32x16_bf16(f0, p3, o[0], 0, 0, 0); f0 = KFR(0);  SBAR(); \
            o[1] = __builtin_amdgcn_mfma_f32_32x32x16_bf16(f1, p3, o[1], 0, 0, 0); f1 = KFR(1);  SBAR(); \
            o[2] = __builtin_amdgcn_mfma_f32_32x32x16_bf16(f2, p3, o[2], 0, 0, 0); f2 = KFR(2);  SBAR(); \
            o[3] = __builtin_amdgcn_mfma_f32_32x32x16_bf16(f3, p3, o[3], 0, 0, 0); f3 = KFR(3);  SBAR(); \
            if (!(FAST_)) { float ma = max3f(C0[0], C0[1], C1[0]), mb = max3f(C0[2], C0[3], C1[1]); ma = max3f(ma, C1[2], C1[3]); \
            _Pragma("unroll") for (int r = 4; r < 16; r += 4) { ma = max3f(ma, C0[r], C0[r + 1]); mb = max3f(mb, C0[r + 2], C0[r + 3]); ma = max3f(ma, C1[r], C1[r + 1]); mb = max3f(mb, C1[r + 2], C1[r + 3]); } \
            const float mx = xhalf_max(max3f(ma, mb, mb)); \
            if (__any(mx > mrow)) { const float mn = max3f(mrow, mx, mx), al = __builtin_amdgcn_exp2f(mrow - mn); lrow *= al; mrow = mn; \
                _Pragma("unroll") for (int i = 0; i < 4; ++i) _Pragma("unroll") for (int r = 0; r < 16; ++r) o[i][r] *= al; } } \
            f32x4 ps = (f32x4){0.f, 0.f, 0.f, 0.f}; \
            N0 = f32x16{}; N1 = f32x16{}; \
            N0 = __builtin_amdgcn_mfma_f32_32x32x16_bf16(f0, qf[0], N0, 0, 0, 0); f0 = KFR(4); EXG(C0, 0, FAST_); SBAR(); \
            N1 = __builtin_amdgcn_mfma_f32_32x32x16_bf16(f1, qf[0], N1, 0, 0, 0); f1 = KFR(5); EXG(C0, 1, FAST_); SBAR(); \
            N0 = __builtin_amdgcn_mfma_f32_32x32x16_bf16(f2, qf[1], N0, 0, 0, 0); f2 = KFR(6); EXG(C0, 2, FAST_); p0 = PACK(C0, 0); SUM4(C0, 0); SUM4(C0, 1); SBAR(); \
            N1 = __builtin_amdgcn_mfma_f32_32x32x16_bf16(f3, qf[1], N1, 0, 0, 0); f3 = KFR(7); EXG(C0, 3, FAST_); SBAR(); \
            N0 = __builtin_amdgcn_mfma_f32_32x32x16_bf16(f0, qf[2], N0, 0, 0, 0); EXG(C1, 0, FAST_); p1 = PACK(C0, 1); SUM4(C0, 2); SUM4(C0, 3); SBAR(); \
            N1 = __builtin_amdgcn_mfma_f32_32x32x16_bf16(f1, qf[2], N1, 0, 0, 0); EXG(C1, 1, FAST_); SBAR(); \
            N0 = __builtin_amdgcn_mfma_f32_32x32x16_bf16(f2, qf[3], N0, 0, 0, 0); EXG(C1, 2, FAST_); p2 = PACK(C1, 0); SUM4(C1, 0); SUM4(C1, 1); SBAR(); \
            N1 = __builtin_amdgcn_mfma_f32_32x32x16_bf16(f3, qf[3], N1, 0, 0, 0); EXG(C1, 3, FAST_); SBAR(); \
            p3 = PACK(C1, 1); SUM4(C1, 2); SUM4(C1, 3); \
            lrow += (ps[0] + ps[1]) + (ps[2] + ps[3]); \
            if ((t_) + 3 < NT) asm volatile("s_waitcnt vmcnt(4) lgkmcnt(0)" ::: "memory"); else if ((t_) + 2 < NT) asm volatile("s_waitcnt vmcnt(2) lgkmcnt(0)" ::: "memory"); else asm volatile("s_waitcnt vmcnt(0) lgkmcnt(0)" ::: "memory"); \
            __builtin_amdgcn_s_barrier(); asm volatile("" ::: "memory"); \
            k0s = k0s == 2 ? 0 : k0s + 1; } while (0)
#define AT_STEP_B0(C0, C1, N0, N1, t_, FAST_) do { \
            if ((t_) + 3 < NT) AT_DMAK((t_) + 3, k0s); if ((t_) + 2 < NT) AT_DMAV((t_) + 2, ((t_) + 2) & 3); \
            const LAS unsigned char* bufK = lds + (k0s == 2 ? 0 : k0s + 1) * AT_KSLOT; int kadl = kad0, vadl = vad0; asm volatile("" : "+v"(kadl), "+v"(vadl)); \
            bf16x8 f0 = KFR(0), f1 = KFR(1), f2 = KFR(2), f3 = KFR(3); \
            if (!(FAST_)) { float ma = max3f(C0[0], C0[1], C1[0]), mb = max3f(C0[2], C0[3], C1[1]); ma = max3f(ma, C1[2], C1[3]); \
            _Pragma("unroll") for (int r = 4; r < 16; r += 4) { ma = max3f(ma, C0[r], C0[r + 1]); mb = max3f(mb, C0[r + 2], C0[r + 3]); ma = max3f(ma, C1[r], C1[r + 1]); mb = max3f(mb, C1[r + 2], C1[r + 3]); } \
            const float mx = xhalf_max(max3f(ma, mb, mb)); \
            if (__any(mx > mrow)) { const float mn = max3f(mrow, mx, mx), al = __builtin_amdgcn_exp2f(mrow - mn); lrow *= al; mrow = mn; \
                _Pragma("unroll") for (int i = 0; i < 4; ++i) _Pragma("unroll") for (int r = 0; r < 16; ++r) o[i][r] *= al; } } \
            f32x4 ps = (f32x4){0.f, 0.f, 0.f, 0.f}; \
            N0 = f32x16{}; N1 = f32x16{}; \
            N0 = __builtin_amdgcn_mfma_f32_32x32x16_bf16(f0, qf[0], N0, 0, 0, 0); f0 = KFR(4); EXG(C0, 0, FAST_); SBAR(); \
            N1 = __builtin_amdgcn_mfma_f32_32x32x16_bf16(f1, qf[0], N1, 0, 0, 0); f1 = KFR(5); EXG(C0, 1, FAST_); SBAR(); \
            N0 = __builtin_amdgcn_mfma_f32_32x32x16_bf16(f2, qf[1], N0, 0, 0, 0); f2 = KFR(6); EXG(C0, 2, FAST_); p0 = PACK(C0, 0); SUM4(C0, 0); SUM4(C0, 1); SBAR(); \
            N1 = __builtin_amdgcn_mfma_f32_32x32x16_bf16(f3, qf[1], N1, 0, 0, 0); f3 = KFR(7); EXG(C0, 3, FAST_); SBAR(); \
            N0 = __builtin_amdgcn_mfma_f32_32x32x16_bf16(f0, qf[2], N0, 0, 0, 0); EXG(C1, 0, FAST_); p1 = PACK(C0, 1); SUM4(C0, 2); SUM4(C0, 3); SBAR(); \
            N1 = __builtin_amdgcn_mfma_f32_32x32x16_bf16(f1, qf[2], N1, 0, 0, 0); EXG(C1, 1, FAST_); SBAR(); \
            N0 = __builtin_amdgcn_mfma_f32_32x32x16_bf16(f2, qf[3], N0, 0, 0, 0); EXG(C1, 2, FAST_); p2 = PACK(C1, 0); SUM4(C1, 0); SUM4(C1, 1); SBAR(); \
            N1 = __builtin_amdgcn_mfma_f32_32x32x16_bf16(f3, qf[3], N1, 0, 0, 0); EXG(C1, 3, FAST_); SBAR(); \
            p3 = PACK(C1, 1); SUM4(C1, 2); SUM4(C1, 3); \
            lrow += (ps[0] + ps[1]) + (ps[2] + ps[3]); \
            if ((t_) + 3 < NT) asm volatile("s_waitcnt vmcnt(4) lgkmcnt(0)" ::: "memory"); else if ((t_) + 2 < NT) asm volatile("s_waitcnt vmcnt(2) lgkmcnt(0)" ::: "memory"); else asm volatile("s_waitcnt vmcnt(0) lgkmcnt(0)" ::: "memory"); \
            __builtin_amdgcn_s_barrier(); asm volatile("" ::: "memory"); \
            k0s = k0s == 2 ? 0 : k0s + 1; } while (0)
#define AT_STEP_BF(t_) do { int vadl = vad0; \
            const LAS unsigned char* bufV = lds + AT_VBASE + (((t_) - 1) & 3) * AT_VSLOT; \
            bf16x8 f0 = VFR(0), f1 = VFR(1), f2 = VFR(2), f3 = VFR(3); \
            o[0] = __builtin_amdgcn_mfma_f32_32x32x16_bf16(f0, p0, o[0], 0, 0, 0); f0 = VFR(4);  SBAR(); \
            o[1] = __builtin_amdgcn_mfma_f32_32x32x16_bf16(f1, p0, o[1], 0, 0, 0); f1 = VFR(5);  SBAR(); \
            o[2] = __builtin_amdgcn_mfma_f32_32x32x16_bf16(f2, p0, o[2], 0, 0, 0); f2 = VFR(6);  SBAR(); \
            o[3] = __builtin_amdgcn_mfma_f32_32x32x16_bf16(f3, p0, o[3], 0, 0, 0); f3 = VFR(7);  SBAR(); \
            o[0] = __builtin_amdgcn_mfma_f32_32x32x16_bf16(f0, p1, o[0], 0, 0, 0); f0 = VFR(8);  SBAR(); \
            o[1] = __builtin_amdgcn_mfma_f32_32x32x16_bf16(f1, p1, o[1], 0, 0, 0); f1 = VFR(9);  SBAR(); \
            o[2] = __builtin_amdgcn_mfma_f32_32x32x16_bf16(f2, p1, o[2], 0, 0, 0); f2 = VFR(10);  SBAR(); \
            o[3] = __builtin_amdgcn_mfma_f32_32x32x16_bf16(f3, p1, o[3], 0, 0, 0); f3 = VFR(11);  SBAR(); \
            o[0] = __builtin_amdgcn_mfma_f32_32x32x16_bf16(f0, p2, o[0], 0, 0, 0); f0 = VFR(12);  SBAR(); \
            o[1] = __builtin_amdgcn_mfma_f32_32x32x16_bf16(f1, p2, o[1], 0, 0, 0); f1 = VFR(13);  SBAR(); \
            o[2] = __builtin_amdgcn_mfma_f32_32x32x16_bf16(f2, p2, o[2], 0, 0, 0); f2 = VFR(14);  SBAR(); \
            o[3] = __builtin_amdgcn_mfma_f32_32x32x16_bf16(f3, p2, o[3], 0, 0, 0); f3 = VFR(15);  SBAR(); \
            o[0] = __builtin_amdgcn_mfma_f32_32x32x16_bf16(f0, p3, o[0], 0, 0, 0);  SBAR(); \
            o[1] = __builtin_amdgcn_mfma_f32_32x32x16_bf16(f1, p3, o[1], 0, 0, 0);  SBAR(); \
            o[2] = __builtin_amdgcn_mfma_f32_32x32x16_bf16(f2, p3, o[2], 0, 0, 0);  SBAR(); \
            o[3] = __builtin_amdgcn_mfma_f32_32x32x16_bf16(f3, p3, o[3], 0, 0, 0);  SBAR(); \
            asm volatile("s_waitcnt vmcnt(0) lgkmcnt(0)" ::: "memory"); __builtin_amdgcn_s_barrier(); asm volatile("" ::: "memory"); } while (0)
    for (int u = vcu; u < 768; u += G) {
        const int bh = u >> 5, qc = u & 31, b = bh / 6, h = bh % 6;
        const int qrow = b * SEQ + qc * 128 + qi * 32 + r32;
        bf16x8 qf[4];
        { const bf16_t* qp = Q + (size_t)qrow * DQK + h * 128 + c * 64 + hi * 8;
#pragma unroll
          for (int d0 = 0; d0 < 4; ++d0) qf[d0] = *(const bf16x8*)(qp + d0 * 16); }
        AT_DMAK(0, 0); AT_DMAK(1, 1); AT_DMAV(0, 0); AT_DMAK(2, 2); AT_DMAV(1, 1);
        asm volatile("s_waitcnt vmcnt(8)" ::: "memory"); __builtin_amdgcn_s_barrier(); asm volatile("" ::: "memory");
        f32x16 o[4];
#pragma unroll
        for (int i = 0; i < 4; ++i) o[i] = f32x16{};
        float mrow = -1e30f, lrow = 0.f;
        f32x16 sa0 = f32x16{}, sa1 = f32x16{}, sb0, sb1;
#pragma unroll
        for (int d0 = 0; d0 < 4; ++d0) {
            const bf16x8 k0 = *(const LAS bf16x8*)(lds + (kad0 ^ (d0 * 32))), k1 = *(const LAS bf16x8*)(lds + (kad0 ^ (d0 * 32)) + 32 * 256);
            sa0 = __builtin_amdgcn_mfma_f32_32x32x16_bf16(k0, qf[d0], sa0, 0, 0, 0);
            sa1 = __builtin_amdgcn_mfma_f32_32x32x16_bf16(k1, qf[d0], sa1, 0, 0, 0); }
        asm volatile("s_waitcnt vmcnt(4) lgkmcnt(0)" ::: "memory"); __builtin_amdgcn_s_barrier(); asm volatile("" ::: "memory");
        int k0s = 0;
#define AT_MAIN(FAST_) do { \
        if (c == 0) { \
            for (int t = 0; t < NT; t += 2) { AT_STEP_A(sa0, sa1, sb0, sb1, t, FAST_); AT_STEP_A(sb0, sb1, sa0, sa1, t + 1, FAST_); } \
            asm volatile("s_waitcnt vmcnt(0) lgkmcnt(0)" ::: "memory"); __builtin_amdgcn_s_barrier(); asm volatile("" ::: "memory");     \
        } else { \
            bf16x8 p0, p1, p2, p3; \
            AT_STEP_B0(sa0, sa1, sb0, sb1, 0, FAST_); \
            for (int t = 1; t < NT - 1; t += 2) { AT_STEP_B(sb0, sb1, sa0, sa1, t, FAST_); AT_STEP_B(sa0, sa1, sb0, sb1, t + 1, FAST_); } \
            AT_STEP_B(sb0, sb1, sa0, sa1, NT - 1, FAST_); \
            AT_STEP_BF(NT); \
        } } while (0)
        if (c == 0) __builtin_amdgcn_s_setprio(3);
        if (fast) AT_MAIN(1); else AT_MAIN(0);
        __builtin_amdgcn_s_setprio(0);
#undef AT_MAIN
        lrow = xhalf_sum(lrow);
        const float inv = 1.0f / lrow;
        LAS float* scr = (LAS float*)lds + (size_t)qi * 4096;
        if (c == 1) {
            const float f = inv * lam;
#pragma unroll
            for (int i = 0; i < 4; ++i)
#pragma unroll
                for (int r = 0; r < 16; ++r) scr[(i * 16 + r) * 64 + lane] = o[i][r] * f;
        }
        __syncthreads();
        if (c == 0) {
            float ss = 0.f;
#pragma unroll
            for (int i = 0; i < 4; ++i)
#pragma unroll
                for (int r = 0; r < 16; ++r) { const float d = o[i][r] * inv - scr[(i * 16 + r) * 64 + lane]; o[i][r] = d; ss += d * d; }
            ss = xhalf_sum(ss);
            const float rn = (1.0f - LAMBDA_INIT) / sqrtf(ss * (1.0f / 128.0f) + RMS_EPS);
            int ln = lane; asm volatile("" : "+v"(ln));
            const int er32 = ln & 31, ehi = ln >> 5;
            LAS unsigned char* stg = lds + 65536 + qi * (32 * 272);
            const float* sg = A.in[I_SUBG] + 4 * ehi;
#pragma unroll
            for (int i = 0; i < 4; ++i)
#pragma unroll
                for (int rq = 0; rq < 4; ++rq) { const f32x4 gq = *(const f32x4*)(sg + 32 * i + 8 * rq);
                    u32x2 w; w.x = cvt_pk_bf16(o[i][4 * rq] * rn * gq[0], o[i][4 * rq + 1] * rn * gq[1]); w.y = cvt_pk_bf16(o[i][4 * rq + 2] * rn * gq[2], o[i][4 * rq + 3] * rn * gq[3]);
                    *(LAS u32x2*)(stg + er32 * 272 + (32 * i + 8 * rq + 4 * ehi) * 2) = w; }
            asm volatile("s_waitcnt lgkmcnt(0)" ::: "memory");
            bf16_t* obase = AO + (size_t)(qrow - r32) * DM + h * 128;
#pragma unroll
            for (int k = 0; k < 8; ++k) { const int row = 4 * k + (ln >> 4), ch = ln & 15;
                const u32x4 v = *(const LAS u32x4*)(stg + row * 272 + ch * 16);
                *(u32x4*)(obase + (size_t)row * DM + ch * 8) = v;
                if (k & 1) asm volatile("" ::: "memory"); }
        }
        __syncthreads();
    }
#undef AT_STEP_A
#undef AT_STEP_B
#undef AT_STEP_B0
#undef AT_STEP_BF
#undef SUM4
#undef PACK
#undef VFR
#undef KFR
#undef EXG
#undef SBAR
#undef AT_DMAK
#undef AT_DMAV
}

#define XB_TMO      128
#define XB_XCNT(j)  (256  + 64 * (j))
#define XB_XSUB(j)  (1280 + 64 * (j))
#define XB_XGEN(j)  (2304 + 64 * (j))
#define XB_TOP      3328
#define XB_TOPGEN   3392
#define XCD_BAR_WORDS 3456
#define XB_SPIN_CAP (1u << 18)

__device__ __forceinline__ unsigned xb_ld(unsigned* p)              { return __hip_atomic_load(p, __ATOMIC_RELAXED, __HIP_MEMORY_SCOPE_AGENT); }
__device__ __forceinline__ unsigned xb_add(unsigned* p, unsigned v) { return __hip_atomic_fetch_add(p, v, __ATOMIC_RELAXED, __HIP_MEMORY_SCOPE_AGENT); }
__device__ __forceinline__ unsigned xb_xcc_id() { return (unsigned)__builtin_amdgcn_s_getreg((3 << 11) | 20) & 0xFu; }
#define XB_SPIN(cond, bar) do { unsigned _sp = 0; while (cond) { __builtin_amdgcn_s_sleep(1); \
    if ((++_sp & 255u) == 0u) { if (xb_ld(&(bar)[XB_TMO])) break; if (_sp > XB_SPIN_CAP) { atomicAdd(&(bar)[XB_TMO], 1u); break; } } } } while (0)

struct XcdBarrier {
    unsigned* bar; unsigned x;
    volatile LAS unsigned* st;
};

__device__ __forceinline__ XcdBarrier xcd_barrier_post(unsigned* bar, volatile LAS unsigned* st) {
    XcdBarrier b; b.bar = bar; b.x = xb_xcc_id(); b.st = st;
    if (threadIdx.x == 0) (void)xb_add(&bar[XB_XCNT(b.x)], 1u);
    return b;
}
__device__ __forceinline__ void xcd_barrier_complete(unsigned* bar, unsigned x, unsigned& nloc, unsigned& nx) {
    const unsigned G = gridDim.x * gridDim.y * gridDim.z;
    unsigned sum, cnt, mine, sp = 0u;
    for (;;) {
        sum = 0u; cnt = 0u; mine = 0u;
#pragma unroll
        for (unsigned j = 0; j < 16; ++j) { const unsigned c = xb_ld(&bar[XB_XCNT(j)]); sum += c; cnt += (c > 0u) ? 1u : 0u; mine = (j == x) ? c : mine; }
        if (sum == G) break;
        __builtin_amdgcn_s_sleep(1);
        if ((++sp & 255u) == 0u) { if (xb_ld(&bar[XB_TMO])) break; if (sp > XB_SPIN_CAP) { atomicAdd(&bar[XB_TMO], 1u); break; } }
    }
    nloc = mine > 0u ? mine : 1u; nx = cnt > 0u ? cnt : 1u;
}

__device__ __forceinline__ void xcd_barrier(const XcdBarrier& b) {
    asm volatile("s_waitcnt vmcnt(0)" ::: "memory");
    __syncthreads();
    if (threadIdx.x == 0) {
        unsigned* bar = b.bar;
        __builtin_amdgcn_s_waitcnt(0);
        unsigned nloc = b.st[0], nx = b.st[1];
        if (nloc == 0u) { xcd_barrier_complete(bar, b.x, nloc, nx); b.st[0] = nloc; b.st[1] = nx; }
        const unsigned old = xb_add(&bar[XB_XSUB(b.x)], 1u);
        const unsigned gen = old / nloc;
        if (old + 1u == (gen + 1u) * nloc) {
            __builtin_amdgcn_fence(__ATOMIC_RELEASE, "agent");
            asm volatile("s_waitcnt vmcnt(0)" ::: "memory");
            const unsigned og = xb_add(&bar[XB_TOP], 1u);
            const unsigned tg = og / nx;
            if (og + 1u == (tg + 1u) * nx) xb_add(&bar[XB_TOPGEN], 1u);
            else XB_SPIN(xb_ld(&bar[XB_TOPGEN]) == tg, bar);
            __builtin_amdgcn_fence(__ATOMIC_ACQUIRE, "agent");
            xb_add(&bar[XB_XGEN(b.x)], 1u);
            asm volatile("s_waitcnt vmcnt(0)" ::: "memory");
        } else {
            XB_SPIN(xb_ld(&bar[XB_XGEN(b.x)]) == gen, bar);
            __builtin_amdgcn_fence(__ATOMIC_ACQUIRE, "agent");
            asm volatile("s_waitcnt vmcnt(0)" ::: "memory");
        }
    }
    __syncthreads();
}

__device__ __forceinline__ void wg_publish(unsigned* cnt) {
    asm volatile("s_waitcnt vmcnt(0)" ::: "memory"); __syncthreads();
    if (threadIdx.x == 0) __hip_atomic_fetch_add(cnt, 1u, __ATOMIC_RELAXED, __HIP_MEMORY_SCOPE_AGENT);
}
__device__ __forceinline__ void wg_await(unsigned* cnt, unsigned want) {
    if (threadIdx.x == 0) { unsigned sp = 0; while (__hip_atomic_load(cnt, __ATOMIC_RELAXED, __HIP_MEMORY_SCOPE_AGENT) < want) { __builtin_amdgcn_s_sleep(1); if (++sp > (1u << 24)) break; }
        __builtin_amdgcn_fence(__ATOMIC_ACQUIRE, "agent"); asm volatile("s_waitcnt vmcnt(0)" ::: "memory"); }
    __syncthreads();
}

__global__ void __launch_bounds__(512, 2) mk_fwd(Args A) {
    extern __shared__ __attribute__((aligned(16))) unsigned char lds_raw[];
    LAS unsigned char* lds = (LAS unsigned char*)lds_raw;
    const int tid = threadIdx.x, lane = tid & 63, wave = __builtin_amdgcn_readfirstlane(tid >> 6);
    const int G = gridDim.x, bx = blockIdx.x, vcu = (G % 8 == 0) ? (bx % 8) * (G / 8) + bx / 8 : bx;
    unsigned char* ws = A.ws;
    const float* mod = (const float*)(ws + WS_MOD);
    bf16_t* XN = (bf16_t*)(ws + WS_XN); bf16_t* Hb = (bf16_t*)(ws + WS_H);
    bf16_t* PARTB = (bf16_t*)(ws + WS_PART);
    const int lo = A.ph_lo, hi = A.ph_hi;
    const int NGW = G * 8;
#define IN(k) (lo <= (k) && (k) < hi)
    const bool fused = (G == 256) && (hi - lo == NPH);
    unsigned* pcnt = (unsigned*)(ws + WS_BAR) + 3584; float* xbuf = (float*)(ws + WS_XBUF);
    bf16_t* XB = (bf16_t*)(ws + WS_DFTM + 16 * MiB);
    unsigned* cctr = (unsigned*)(ws + WS_BAR) + 3840; unsigned* gcnt = (unsigned*)(ws + WS_BAR) + 3856;
#define PH_TID() int ptid = threadIdx.x; asm volatile("" : "+v"(ptid)); const int plane = ptid & 63; const int pwave = __builtin_amdgcn_readfirstlane(ptid >> 6); const int pgw = vcu * 8 + pwave; (void)plane; (void)pgw
    volatile LAS unsigned* bst = (volatile LAS unsigned*)(lds + 131072 + 64);
    if (tid < 2) bst[tid] = 0u;
    __syncthreads();
    XcdBarrier bar; bar.bar = (unsigned*)(ws + WS_BAR); bar.x = 0; bar.st = bst;
    if (hi - lo > 1) bar = xcd_barrier_post((unsigned*)(ws + WS_BAR), bst);
    if (lo < 0) cg::this_grid().sync();
#define SEAM(k) do { if (IN(k) && IN((k) + 1)) xcd_barrier(bar); } while (0)

    if (IN(0)) { PH_TID(); prologue(A, lds, vcu, G, ptid); }
    if (!fused) SEAM(0);
    if (IN(1)) { PH_TID();
        if (fused) wg_await(gcnt, 128u);
        int ma = pgw;
        for (; ma + NGW < MLAT; ma += 2 * NGW) { const int mb = ma + NGW; const float* pa = mod + (ma / SEQ) * MODLD; const float* pb = mod + (mb / SEQ) * MODLD;
            rownorm2<true>(A.in[I_X] + (size_t)ma * DM, A.in[I_X] + (size_t)mb * DM, A.in[I_N1G], pa, pa + DM, pb, pb + DM, XN + (size_t)ma * DM, XN + (size_t)mb * DM, nullptr, nullptr, plane); }
        if (ma < MLAT) { const float* pa = mod + (ma / SEQ) * MODLD; rownorm1<true>(A.in[I_X] + (size_t)ma * DM, nullptr, A.in[I_N1G], pa, pa + DM, XN + (size_t)ma * DM, nullptr, plane); }
        for (int r = pgw; r < MCTX; r += NGW)
            rownorm1<true>(A.in[I_CTX] + (size_t)r * DM, nullptr, A.in[I_N1G], mod + NB * MODLD + 0 * DM, mod + NB * MODLD + 1 * DM, XN + (size_t)(MLAT + r) * DM, nullptr, plane);
    }
    SEAM(1);
    if (IN(2)) { PH_TID();
        pg8::Order S{}; S.nseg = 1; S.G = G; S.c = bx; S.s0 = pg8::Seg{MALL / 256, 22, 0, (const char*)XN, (const char*)(ws + WS_WGU1), (size_t)256 * DM * 2, (size_t)256 * DM * 2}; S.total = (MALL / 256) * 22;
        pg8::EpiSwiGLU E{Hb};
        pg8::gemm_phase(lds, pg8::Gemm{DM, DM, DM}, S, E, ptid);
        { int ptid3 = threadIdx.x; asm volatile("" : "+v"(ptid3)); const int rem = S.total % G;
          if (rem == 0) weight_transposes(A, lds, vcu, G, ptid3, 1); else if (bx >= rem) weight_transposes(A, lds, bx - rem, G - rem, ptid3, 1); }
    }
    SEAM(2);
    if (IN(3)) { PH_TID();
        pg8::Order S2{}; S2.nseg = 1; S2.G = G; S2.c = bx; S2.s0 = pg8::Seg{MCTX / 256, 4, 0, (const char*)(Hb + (size_t)MLAT * DFF), (const char*)(ws + WS_WD1), (size_t)256 * DFF * 2, (size_t)256 * DFF * 2, 11, 512, 512}; S2.total = 4 * 4 * 11;
        pg8::EpiCtxPart E2{PARTB, mod + 2 * DM, 0.5f};
        pg8::gemm_phase(lds, pg8::Gemm{256, DFF, DFF}, S2, E2, ptid);
        if (fused) wg_publish(cctr);
        pg8::Order S{}; S.nseg = 1; S.G = G; S.c = bx; S.s0 = pg8::Seg{MLAT / 256, 4, 0, (const char*)Hb, (const char*)(ws + WS_WD1), (size_t)256 * DFF * 2, (size_t)256 * DFF * 2, 1, 0, 0}; S.total = (MLAT / 256) * 4;
        if (fused) { pg8::EpiResidNorm<0, false> E{A.in[I_X], A.out, mod + 2 * DM, 0.5f, A.in[I_NMG], mod + 3 * DM, mod + 4 * DM, XN, xbuf, pcnt, XB};
            pg8::gemm_phase(lds, pg8::Gemm{DFF, DFF, DFF}, S, E, ptid);
            wg_await(cctr, (unsigned)G);
            if (pwave < 4) { const int r = vcu * 4 + pwave;
                rownorm1<true>(A.in[I_CTX] + (size_t)r * DM, PARTB + (size_t)r * DM, A.in[I_NMG], mod + NB * MODLD + 3 * DM, mod + NB * MODLD + 4 * DM, XN + (size_t)(MLAT + r) * DM, nullptr, plane); } }
        else { pg8::EpiResid E{A.in[I_X], A.out, nullptr, nullptr, mod + 2 * DM, 0.5f};
            pg8::gemm_phase(lds, pg8::Gemm{DFF, DFF, DFF}, S, E, ptid); }
    }
    if (!fused) SEAM(3);
    if (IN(4) && !fused) { PH_TID();
        int ma = pgw;
        for (; ma + NGW < MLAT; ma += 2 * NGW) { const int mb = ma + NGW; const float* pa = mod + (ma / SEQ) * MODLD + 3 * DM; const float* pb = mod + (mb / SEQ) * MODLD + 3 * DM;
            rownorm2<true>(A.out + (size_t)ma * DM, A.out + (size_t)mb * DM, A.in[I_NMG], pa, pa + DM, pb, pb + DM, XN + (size_t)ma * DM, XN + (size_t)mb * DM, nullptr, nullptr, plane); }
        if (ma < MLAT) { const float* pa = mod + (ma / SEQ) * MODLD + 3 * DM; rownorm1<true>(A.out + (size_t)ma * DM, nullptr, A.in[I_NMG], pa, pa + DM, XN + (size_t)ma * DM, nullptr, plane); }
        for (int r = pgw; r < MCTX; r += NGW)
            rownorm1<true>(A.in[I_CTX] + (size_t)r * DM, PARTB + (size_t)r * DM, A.in[I_NMG], mod + NB * MODLD + 3 * DM, mod + NB * MODLD + 4 * DM, XN + (size_t)(MLAT + r) * DM, nullptr, plane);
    }
    SEAM(4);
    if (IN(5)) { PH_TID();
        const char* WIN = (const char*)(ws + WS_WIN); const size_t T = (size_t)256 * DM * 2;
        pg8::Order S{}; S.nseg = 4; S.G = G; S.c = bx;
        S.s0 = pg8::Seg{MLAT / 256, 3, 0, (const char*)XN, WIN, T, T};
        S.s1 = pg8::Seg{MALL / 256, 3, 1, (const char*)XN, WIN + 3 * T, T, T};
        S.s2 = pg8::Seg{3, MALL / 256, 2, WIN + 6 * T, (const char*)XN, T, T};
        S.s3 = pg8::Seg{2, MLAT / 256, 3, (const char*)(ws + WS_WF), (const char*)XN, T, T};
        S.total = 64 * 3 + 68 * 3 + 3 * 68 + 2 * 64;
        pg8::EpiInProj E{(bf16_t*)(ws + WS_Q), (bf16_t*)(ws + WS_K), (bf16_t*)(ws + WS_VT), (bf16_t*)(ws + WS_DFTB), (const float*)(ws + WS_ROPE), (const float*)(ws + WS_ROPE) + 1024, (unsigned*)(ws + WS_BAR) + 3456};
        pg8::gemm_phase<pg8::EpiInProj, true>(lds, pg8::Gemm{DM, DM, DM}, S, E, ptid);
        { int ptid3 = threadIdx.x; asm volatile("" : "+v"(ptid3)); const int rem = S.total % G;
          if (rem == 0) { weight_transposes(A, lds, vcu, G, ptid3, 2); weight_transposes(A, lds, vcu, G, ptid3, 4); }
          else if (bx >= rem) { weight_transposes(A, lds, bx - rem, G - rem, ptid3, 2); weight_transposes(A, lds, bx - rem, G - rem, ptid3, 4); } }
    }
    SEAM(5);
    if (IN(6)) { PH_TID();
        unsigned* fcnt = (unsigned*)(ws + WS_BAR) + 3968;
        { pg8::Order S{}; S.nseg = 1; S.G = G; S.c = bx; S.s0 = pg8::Seg{1, 256, 0, (const char*)(ws + WS_M1), (const char*)(ws + WS_DFTB), 0, (size_t)256 * 128 * 2}; S.total = 256;
          pg8::EpiFFT1 E{(bf16_t*)(ws + WS_YT), (const f32x2*)(ws + WS_TW)};
          pg8::gemm_phase(lds, pg8::Gemm{128, 128, 128}, S, E, ptid); }
        wg_publish(fcnt);
        { int ptid1 = threadIdx.x; asm volatile("" : "+v"(ptid1)); attn_phase(A, lds, vcu, G, ptid1); }
        if (threadIdx.x == 0) { unsigned sp = 0; while (__hip_atomic_load(fcnt, __ATOMIC_RELAXED, __HIP_MEMORY_SCOPE_AGENT) < (unsigned)G) { __builtin_amdgcn_s_sleep(2); if (++sp > (1u << 24)) break; }
            __builtin_amdgcn_fence(__ATOMIC_ACQUIRE, "agent"); asm volatile("s_waitcnt vmcnt(0)" ::: "memory"); }
        __syncthreads();
        { int ptid2 = threadIdx.x; asm volatile("" : "+v"(ptid2));
          pg8::Order S{}; S.nseg = 1; S.G = G; S.c = bx; S.s0 = pg8::Seg{1, 256, 0, (const char*)(ws + WS_M2), (const char*)(ws + WS_YT), 0, (size_t)256 * 128 * 2}; S.total = 256;
          pg8::EpiFFT2 E{(bf16_t*)(ws + WS_AO)};
          pg8::gemm_phase(lds, pg8::Gemm{128, 128, 128}, S, E, ptid2); }
    }
    SEAM(6);
    if (IN(7)) { PH_TID();
        pg8::Order S{}; S.nseg = 1; S.G = G; S.c = bx; S.s0 = pg8::Seg{MLAT / 256, 4, 0, (const char*)(ws + WS_AO), (const char*)(ws + WS_WO), (size_t)256 * DM * 2, (size_t)256 * DM * 2}; S.total = 256;
        if (fused) { pg8::EpiResidNorm<0, true> E{A.out, A.out, mod + 5 * DM, 1.0f, A.in[I_N2G], mod + 6 * DM, mod + 7 * DM, XN, xbuf + 65536, pcnt + 64, XB};
            pg8::gemm_phase(lds, pg8::Gemm{DM, DM, DM}, S, E, ptid); }
        else { pg8::EpiResid E{A.out, A.out, nullptr, nullptr, mod + 5 * DM, 1.0f};
            pg8::gemm_phase(lds, pg8::Gemm{DM, DM, DM}, S, E, ptid); }
    }
    if (!fused) SEAM(7);
    if (IN(8) && !fused) { PH_TID();
        int ma = pgw;
        for (; ma + NGW < MLAT; ma += 2 * NGW) { const int mb = ma + NGW; const float* pa = mod + (ma / SEQ) * MODLD + 6 * DM; const float* pb = mod + (mb / SEQ) * MODLD + 6 * DM;
            rownorm2<true>(A.out + (size_t)ma * DM, A.out + (size_t)mb * DM, A.in[I_N2G], pa, pa + DM, pb, pb + DM, XN + (size_t)ma * DM, XN + (size_t)mb * DM, nullptr, nullptr, plane); }
        if (ma < MLAT) { const float* pa = mod + (ma / SEQ) * MODLD + 6 * DM; rownorm1<true>(A.out + (size_t)ma * DM, nullptr, A.in[I_N2G], pa, pa + DM, XN + (size_t)ma * DM, nullptr, plane); }
    }
    SEAM(8);
    if (IN(9)) { PH_TID();
        pg8::Order S{}; S.nseg = 1; S.G = G; S.c = bx; S.s0 = pg8::Seg{MLAT / 256, 22, 0, (const char*)XN, (const char*)(ws + WS_WGU2), (size_t)256 * DM * 2, (size_t)256 * DM * 2}; S.total = 64 * 22;
        pg8::EpiSwiGLU E{Hb};
        pg8::gemm_phase(lds, pg8::Gemm{DM, DM, DM}, S, E, ptid);
        { int ptid3 = threadIdx.x; asm volatile("" : "+v"(ptid3)); const int rem = S.total % G;
          if (rem == 0) weight_transposes(A, lds, vcu, G, ptid3, 3); else if (bx >= rem) weight_transposes(A, lds, bx - rem, G - rem, ptid3, 3); }
    }
    SEAM(9);
    if (IN(10)) { PH_TID();
        pg8::Order S{}; S.nseg = 1; S.G = G; S.c = bx; S.s0 = pg8::Seg{MLAT / 256, 4, 0, (const char*)Hb, (const char*)(ws + WS_WD2), (size_t)256 * DFF * 2, (size_t)256 * DFF * 2}; S.total = 256;
        if (fused) { pg8::EpiResidNorm<1, true> E{A.out, A.out, mod + 8 * DM, 0.5f, A.in[I_FNG], nullptr, nullptr, nullptr, xbuf + 131072, pcnt + 128, XB};
            pg8::gemm_phase(lds, pg8::Gemm{DFF, DFF, DFF}, S, E, ptid); }
        else { pg8::EpiResid E{A.out, A.out, nullptr, nullptr, mod + 8 * DM, 0.5f};
            pg8::gemm_phase(lds, pg8::Gemm{DFF, DFF, DFF}, S, E, ptid); }
    }
    if (!fused) SEAM(10);
    if (IN(11) && !fused) { PH_TID();
        int ma = pgw;
        for (; ma + NGW < MLAT; ma += 2 * NGW) { const int mb = ma + NGW;
            rownorm2<false>(A.out + (size_t)ma * DM, A.out + (size_t)mb * DM, A.in[I_FNG], nullptr, nullptr, nullptr, nullptr, nullptr, nullptr, A.out + (size_t)ma * DM, A.out + (size_t)mb * DM, plane); }
        if (ma < MLAT) rownorm1<false>(A.out + (size_t)ma * DM, nullptr, A.in[I_FNG], nullptr, nullptr, nullptr, A.out + (size_t)ma * DM, plane);
    }
#undef IN
#undef SEAM
}

extern "C" void kernel_launch(void* const* d_in, const int* in_sizes, int n_in, void* d_out, int out_size, void* d_ws, size_t ws_size, hipStream_t stream) {
    static int grid = 0;
    if (grid == 0) {
        if (n_in != 24 || out_size != MLAT * DM || ws_size < WS_END) { fprintf(stderr, "kernel_launch: unexpected shapes (n_in %d out %d ws %zu)\n", n_in, out_size, ws_size); grid = -1; return; }
        int dev = 0, cus = 0, per_cu = 0;
        hipGetDevice(&dev); hipDeviceGetAttribute(&cus, hipDeviceAttributeMultiprocessorCount, dev);
        hipFuncSetAttribute((const void*)mk_fwd, hipFuncAttributeMaxDynamicSharedMemorySize, LDS_BYTES);
        hipOccupancyMaxActiveBlocksPerMultiprocessor(&per_cu, (const void*)mk_fwd, 512, LDS_BYTES);
        if (per_cu < 1) { fprintf(stderr, "kernel_launch: occupancy query says %d blocks per CU\n", per_cu); per_cu = 1; }
        (void)hipGetLastError();
        grid = cus;
        if (grid % 8) grid -= grid % 8;
    }
    if (grid < 0) return;
    Args a{};
    for (int i = 0; i < 24; ++i) a.in[i] = (const float*)d_in[i];
    a.out = (float*)d_out; a.ws = (unsigned char*)d_ws;
#if MK_N_LAUNCHES == 1
    (void)hipMemsetAsync((char*)d_ws + WS_BAR, 0, BAR_BYTES, stream);
    a.ph_lo = 0; a.ph_hi = NPH;
    void* args[] = {&a};
    hipError_t e = hipLaunchCooperativeKernel((const void*)mk_fwd, dim3(grid), dim3(512), args, LDS_BYTES, stream);
    if (e != hipSuccess) fprintf(stderr, "cooperative launch failed: %s (grid %d)\n", hipGetErrorString(e), grid);
#else
    for (int p = 0; p < NPH; ++p) { a.ph_lo = p; a.ph_hi = p + 1; hipLaunchKernelGGL(mk_fwd, dim3(grid), dim3(512), LDS_BYTES, stream, a); }
#endif
}
```

```cpp
#include <hip/hip_runtime.h>
#include <hip/hip_cooperative_groups.h>
#include <cstdio>
#include <cstdint>
namespace cg = cooperative_groups;

#ifndef MK_N_LAUNCHES
#define MK_N_LAUNCHES 1
#endif

#define LAS __attribute__((address_space(3)))
typedef unsigned short bf16_t;
typedef short bf16x8 __attribute__((ext_vector_type(8)));
typedef float f32x4 __attribute__((ext_vector_type(4)));
typedef float f32x2 __attribute__((ext_vector_type(2)));
typedef float f32x16 __attribute__((ext_vector_type(16)));
typedef unsigned u32x4 __attribute__((ext_vector_type(4)));
typedef unsigned u32x2 __attribute__((ext_vector_type(2)));

constexpr int DM = 1024, NB = 4, SEQ = 4096, CTXL = 256, MLAT = NB * SEQ, MCTX = NB * CTXL, MALL = MLAT + MCTX;
constexpr int DFF = 2816, MODLD = 9216, DQK = 768;
constexpr int NPH = 12;
constexpr float RMS_EPS = 1e-6f;
constexpr float QSCALE = 0.125f * 1.4426950408889634f;
constexpr float LAMBDA_INIT = 0.2f;

constexpr size_t MiB = 1u << 20;
constexpr size_t WS_SCAL = 0, WS_MOD = 4096, WS_ROPE = 256 * 1024, WS_BAR = 512 * 1024, BAR_BYTES = 16384, WS_M1 = 576 * 1024, WS_M2 = 640 * 1024, WS_TW = 704 * 1024;
constexpr size_t HM = MiB / 2;
constexpr size_t WS_WGU1 = 2 * HM, WS_WD1 = 24 * HM, WS_WGU2 = 35 * HM, WS_WD2 = 57 * HM, WS_WIN = 68 * HM, WS_WF = 77 * HM, WS_WO = 79 * HM;
constexpr size_t WS_DFTM = 83 * HM, WS_YT = WS_DFTM, WS_XN = 211 * HM, WS_AO = WS_XN, WS_H = 279 * HM;
constexpr size_t WS_Q = 279 * HM, WS_K = 327 * HM, WS_VT = 378 * HM, WS_DFTB = 429 * HM;
constexpr size_t WS_PART = 466 * HM, WS_XBUF = 510 * HM, WS_END = 512 * HM;
static_assert(WS_H + (size_t)17408 * 2816 * 2 <= WS_PART && WS_DFTB + 16 * MiB <= WS_PART && WS_XN + 34 * MiB <= WS_H && WS_DFTM + 64 * MiB <= WS_XN && WS_WO + 2 * MiB <= WS_DFTM, "ws map");

constexpr int LDS_BYTES = 132096;

__device__ __forceinline__ unsigned cvt_pk_bf16(float lo, float hi) { unsigned r; asm volatile("v_cvt_pk_bf16_f32 %0, %1, %2" : "=v"(r) : "v"(lo), "v"(hi)); return r; }
__device__ __forceinline__ float wave_sum(float v) {
#pragma unroll
    for (int o = 1; o < 64; o <<= 1) v += __shfl_xor(v, o);
    return v;
}
__device__ __forceinline__ float silu_f(float g) { return g * __builtin_amdgcn_rcpf(1.0f + __builtin_amdgcn_exp2f(-1.4426950408889634f * g)); }

namespace pg8 {
constexpr int BM = 256, BK = 64, HALF = 128, HTB = HALF * BK * 2, STAGE_BYTES = 8 * HTB, WGM = 4;
__host__ __device__ __forceinline__ int lds_byte(int r, int c) { const int st = (r >> 4) * 2 + (c >> 5), rr = r & 15, cc = c & 31, ob = rr * 64 + cc * 2; return st * 1024 + (ob ^ (((ob >> 9) & 1) << 5)); }
__host__ __device__ __forceinline__ void stage_rc(int b, int& R, int& C) { const int st = b / 1024, sb = b % 1024, swz = sb ^ (((sb >> 9) & 1) << 5); R = (st >> 1) * 16 + swz / 64; C = (st & 1) * 32 + (swz % 64) / 2; }
__host__ __device__ __forceinline__ int perm32(int rho) { const int n = rho >> 4, i = rho & 15; return 8 * (i >> 2) + 4 * n + (i & 3); }

struct Unit { int pm, pn, kind, ks; const char* a; const char* b; };
struct Gemm { int K, lda, ldb; };

struct Seg { int nM, nN, kind; const char* a; const char* b; size_t ta, tb; int nks; size_t ka, kb; };
__device__ __forceinline__ bool seg_take(const Seg& s, int& w, Unit& u) {
    const int nks = s.nks > 1 ? s.nks : 1; const int n = s.nM * s.nN * nks;
    if (w >= n) { w -= n; return false; }
    const int ks = w % nks; w /= nks; u.ks = ks;
    const int nig = WGM * s.nN, gid = w / nig, fm = gid * WGM, gsz = (s.nM - fm) < WGM ? (s.nM - fm) : WGM;
    u.pm = fm + ((w % nig) % gsz); u.pn = (w % nig) / gsz; u.kind = s.kind;
    u.a = s.a + (size_t)u.pm * s.ta + (size_t)ks * s.ka; u.b = s.b + (size_t)u.pn * s.tb + (size_t)ks * s.kb;
    if (s.kind == 3) u.b = s.b + (size_t)((u.pn >> 4) * SEQ + (u.pn & 15) * 4) * (DM * 2);
    return true;
}
struct Order {
    Seg s0, s1, s2, s3; int nseg, G, c, total;
    __device__ __forceinline__ bool next(int i, Unit& u) const {
        const long L = (long)i * G + c; if (L >= total) return false;
        int w = (int)L; { const int q = total / 8, r = total % 8, xcd = w % 8, off = w / 8; w = (xcd < r ? xcd * (q + 1) : r * (q + 1) + (xcd - r) * q) + off; }
        if (seg_take(s0, w, u)) return true;
        if (nseg > 1 && seg_take(s1, w, u)) return true;
        if (nseg > 2 && seg_take(s2, w, u)) return true;
        if (nseg > 3 && seg_take(s3, w, u)) return true;
        return false;
    }
};

template <class Epi, bool BSEL = false>
__device__ __forceinline__ void gemm_phase(LAS unsigned char* lds, const Gemm g, const Order& S, const Epi& E, const int tid) {
    constexpr bool ALIGN_EPI = true;
    const int wid = __builtin_amdgcn_readfirstlane(tid >> 6), lane = tid & 63, wr = wid >> 2, wc = wid & 3, fr = lane & 15, fq = lane >> 4;
    const int K = g.K, nt = K / BK;
    unsigned voffA[2], voffB[2], voffBp[2];
#pragma unroll
    for (int i = 0; i < 2; ++i) { int R, C; stage_rc(tid * 16 + i * 8192, R, C); const int Rb = Epi::PERM ? ((R & ~31) + perm32(R & 31)) : R;
        voffA[i] = (unsigned)(R * g.lda + C) * 2u; voffB[i] = (unsigned)(Rb * g.ldb + C) * 2u;
        voffBp[i] = (unsigned)((64 * (Rb & 63) + (Rb >> 6)) * g.ldb + C) * 2u; }
    const size_t kstep = (size_t)(BK * 2);
    const size_t hstepA = (size_t)HALF * g.lda * 2, hstepBn = (size_t)HALF * g.ldb * 2, hstepBp = (size_t)2 * g.ldb * 2;
    const unsigned ldsw = (unsigned)wid * 1024u;
    const int aoff = lds_byte(wr * 64 + fr, fq * 8), boff = lds_byte(wc * 32 + fr, fq * 8);
#define PG8_SA(b, h) (((b) * 2 + (h)) * HTB)
#define PG8_SB(b, h) ((4 + (b) * 2 + (h)) * HTB)
#define PG8_STAGE(bufoff, gbase, voff) do { _Pragma("unroll") for (int _i = 0; _i < 2; ++_i) \
        __builtin_amdgcn_global_load_lds((const unsigned*)((const char*)(gbase) + (voff)[_i]), (LAS unsigned*)(lds + (bufoff) + ldsw + _i * 8192), 16, 0, 0); } while (0)
#define PG8_STAGEB(bufoff, gbase, perm) do { _Pragma("unroll") for (int _i = 0; _i < 2; ++_i) \
        __builtin_amdgcn_global_load_lds((const unsigned*)((const char*)(gbase) + ((BSEL && (perm)) ? voffBp[_i] : voffB[_i])), (LAS unsigned*)(lds + (bufoff) + ldsw + _i * 8192), 16, 0, 0); } while (0)
#define PG8_LDA(dst, b, h) do { _Pragma("unroll") for (int m = 0; m < 4; ++m) _Pragma("unroll") for (int k = 0; k < 2; ++k) dst[m][k] = *(const LAS bf16x8*)(lds + PG8_SA(b, h) + aoff + m * 2048 + k * 1024); } while (0)
#define PG8_LDB(dst, b, h) do { _Pragma("unroll") for (int n = 0; n < 2; ++n) _Pragma("unroll") for (int k = 0; k < 2; ++k) dst[n][k] = *(const LAS bf16x8*)(lds + PG8_SB(b, h) + boff + n * 2048 + k * 1024); } while (0)
#define PG8_MMA(ai, bj, At, Bt) do { __builtin_amdgcn_s_setprio(1); _Pragma("unroll") for (int m = 0; m < 4; ++m) _Pragma("unroll") for (int n = 0; n < 2; ++n) _Pragma("unroll") for (int k = 0; k < 2; ++k) \
        acc[ai][bj][m][n] = __builtin_amdgcn_mfma_f32_16x16x32_bf16(Bt[n][k], At[m][k], acc[ai][bj][m][n], 0, 0, 0); __builtin_amdgcn_s_setprio(0); } while (0)
#define PG8_WAIT_V(n) asm volatile("s_waitcnt vmcnt(" #n ")" ::: "memory")
#define PG8_WAIT_L(n) asm volatile("s_waitcnt lgkmcnt(" #n ")" ::: "memory")
#define PG8_BAR __builtin_amdgcn_s_barrier()
#define PG8_SCHED __builtin_amdgcn_sched_barrier(0)
    Unit cur, nxt; int ui = 0;
    if (!S.next(0, cur)) return;
    f32x4 acc[2][2][4][2];
#pragma unroll
    for (int a = 0; a < 2; ++a)
#pragma unroll
        for (int b = 0; b < 2; ++b)
#pragma unroll
            for (int m = 0; m < 4; ++m)
#pragma unroll
                for (int n = 0; n < 2; ++n) acc[a][b][m][n] = (f32x4){0.f, 0.f, 0.f, 0.f};
    bf16x8 At[4][2], B0[2][2], B1[2][2];
    const char* cA = cur.a; const char* cB = cur.b;
    bool cP = BSEL && cur.kind == 3; size_t chB = cP ? hstepBp : hstepBn;
    PG8_STAGEB(PG8_SB(0, 0), cB, cP); PG8_STAGEB(PG8_SB(0, 1), cB + chB, cP); PG8_STAGE(PG8_SA(0, 0), cA, voffA); PG8_STAGE(PG8_SA(0, 1), cA + hstepA, voffA);
    if (wr == 1) PG8_BAR;
    PG8_WAIT_V(2); PG8_BAR;
    PG8_STAGEB(PG8_SB(1, 0), cB + kstep, cP); PG8_STAGE(PG8_SA(1, 0), cA + kstep, voffA); PG8_STAGEB(PG8_SB(1, 1), cB + chB + kstep, cP);
    PG8_WAIT_V(6); PG8_BAR;
    for (;;) {
        const bool has_next = S.next(ui + 1, nxt);
        const char* nA = has_next ? nxt.a : cA; const char* nB = has_next ? nxt.b : cB;
        const bool nP = has_next ? (BSEL && nxt.kind == 3) : cP; const size_t nhB = nP ? hstepBp : hstepBn;
        for (int t = 0; t < nt; t += 2) {
            const bool last = (t == nt - 2);
            const char* a1 = cA + (size_t)(t + 1) * kstep;
            const char* a2 = last ? nA : cA + (size_t)(t + 2) * kstep; const char* b2 = last ? nB : cB + (size_t)(t + 2) * kstep;
            const char* a3 = a2 + kstep; const char* b3 = b2 + kstep;
            const bool p2 = last ? nP : cP; const size_t h2 = last ? nhB : chB;
            PG8_LDB(B0, 0, 0); PG8_LDB(B1, 0, 1); PG8_SCHED; PG8_LDA(At, 0, 0); PG8_STAGE(PG8_SA(1, 1), a1 + hstepA, voffA);
            PG8_WAIT_V(8); PG8_WAIT_L(0); PG8_BAR; PG8_MMA(0, 0, At, B0); PG8_MMA(0, 1, At, B1); PG8_BAR; PG8_SCHED;
            PG8_LDA(At, 0, 1); PG8_STAGEB(PG8_SB(0, 0), b2, p2); PG8_STAGEB(PG8_SB(0, 1), b2 + h2, p2); PG8_STAGE(PG8_SA(0, 0), a2, voffA);
            PG8_WAIT_V(8); PG8_WAIT_L(0); PG8_BAR; PG8_MMA(1, 0, At, B0); PG8_MMA(1, 1, At, B1); PG8_BAR; PG8_SCHED;
            PG8_LDB(B0, 1, 0); PG8_LDB(B1, 1, 1); PG8_SCHED; PG8_LDA(At, 1, 0); PG8_STAGE(PG8_SA(0, 1), a2 + hstepA, voffA);
            PG8_WAIT_V(8); PG8_WAIT_L(0); PG8_BAR; PG8_MMA(0, 0, At, B0); PG8_MMA(0, 1, At, B1); PG8_BAR; PG8_SCHED;
            PG8_LDA(At, 1, 1); PG8_STAGEB(PG8_SB(1, 0), b3, p2); PG8_STAGEB(PG8_SB(1, 1), b3 + h2, p2); PG8_STAGE(PG8_SA(1, 0), a3, voffA);
            PG8_WAIT_V(8); PG8_WAIT_L(0); PG8_BAR; PG8_MMA(1, 0, At, B0); PG8_MMA(1, 1, At, B1); PG8_BAR; PG8_SCHED;
        }
        if constexpr (ALIGN_EPI) { if (wr == 0) PG8_BAR; }
        if constexpr (!Epi::AFTER_DRAIN) E(acc, cur, wr, wc, fr, fq);
        if (!has_next) break;
#pragma unroll
        for (int a = 0; a < 2; ++a)
#pragma unroll
            for (int b = 0; b < 2; ++b)
#pragma unroll
                for (int m = 0; m < 4; ++m)
#pragma unroll
                    for (int n = 0; n < 2; ++n) acc[a][b][m][n] = (f32x4){0.f, 0.f, 0.f, 0.f};
        cur = nxt; cA = nA; cB = nB; cP = nP; chB = nhB; ++ui;
        if constexpr (ALIGN_EPI) { if (wr == 1) PG8_BAR; }
    }
    PG8_WAIT_V(0);
    if constexpr (!ALIGN_EPI) { if (wr == 0) PG8_BAR; }
    PG8_BAR;
    if constexpr (Epi::AFTER_DRAIN) E.fused(acc, cur, wr, wc, fr, fq, lds, tid);
#undef PG8_SA
#undef PG8_SB
#undef PG8_STAGE
#undef PG8_STAGEB
#undef PG8_LDA
#undef PG8_LDB
#undef PG8_MMA
#undef PG8_WAIT_V
#undef PG8_WAIT_L
#undef PG8_BAR
#undef PG8_SCHED
}


struct EpiSwiGLU {
    static constexpr bool PERM = true, AFTER_DRAIN = false;
    bf16_t* H;
    __device__ __forceinline__ void operator()(const f32x4 (&acc)[2][2][4][2], const Unit& u, int wr, int wc, int fr, int fq) const {
        const int row0 = u.pm * BM + wr * 64 + fr, col0 = u.pn * 128 + wc * 32 + 8 * fq;
#pragma unroll
        for (int ai = 0; ai < 2; ++ai)
#pragma unroll
            for (int m = 0; m < 4; ++m) {
                bf16_t* rowp = H + (size_t)(row0 + ai * HALF + m * 16) * DFF + col0;
                const f32x4 g0 = acc[ai][0][m][0], g1 = acc[ai][0][m][1], u0 = acc[ai][1][m][0], u1 = acc[ai][1][m][1];
                u32x4 w;
                w.x = cvt_pk_bf16(silu_f(g0[0]) * u0[0], silu_f(g0[1]) * u0[1]); w.y = cvt_pk_bf16(silu_f(g0[2]) * u0[2], silu_f(g0[3]) * u0[3]);
                w.z = cvt_pk_bf16(silu_f(g1[0]) * u1[0], silu_f(g1[1]) * u1[1]); w.w = cvt_pk_bf16(silu_f(g1[2]) * u1[2], silu_f(g1[3]) * u1[3]);
                *(u32x4*)rowp = w;
            }
    }
};
struct EpiResid {
    static constexpr bool PERM = false, AFTER_DRAIN = false;
    const float* base_lat; float* out_lat; const float* base_ctx; float* out_ctx; const float* gate; float coef;
    __device__ __forceinline__ void operator()(const f32x4 (&acc)[2][2][4][2], const Unit& u, int wr, int wc, int fr, int fq) const {
        const bool lat = u.pm < MLAT / BM; const int cls = lat ? u.pm / (SEQ / BM) : NB;
        const float* base = lat ? base_lat + (size_t)u.pm * BM * DM : base_ctx + (size_t)(u.pm - MLAT / BM) * BM * DM;
        float* out = lat ? out_lat + (size_t)u.pm * BM * DM : out_ctx + (size_t)(u.pm - MLAT / BM) * BM * DM;
        const int col0 = u.pn * BM + wc * 32 + 4 * fq;
        f32x4 gv[2][2];
#pragma unroll
        for (int bj = 0; bj < 2; ++bj)
#pragma unroll
            for (int n = 0; n < 2; ++n) gv[bj][n] = *(const f32x4*)(gate + (size_t)cls * MODLD + col0 + bj * HALF + n * 16) * coef;
#pragma unroll
        for (int ai = 0; ai < 2; ++ai)
#pragma unroll
            for (int m = 0; m < 4; ++m) { const size_t off = (size_t)(ai * HALF + wr * 64 + m * 16 + fr) * DM + col0;
#pragma unroll
                for (int bj = 0; bj < 2; ++bj)
#pragma unroll
                    for (int n = 0; n < 2; ++n) { const f32x4 bs = *(const f32x4*)(base + off + bj * HALF + n * 16);
                        *(f32x4*)(out + off + bj * HALF + n * 16) = bs + gv[bj][n] * acc[ai][bj][m][n]; }
                asm volatile("" ::: "memory"); }
    }
};
struct EpiCtxPart {
    static constexpr bool PERM = true, AFTER_DRAIN = false;
    bf16_t* PART; const float* gate; float coef;
    __device__ __forceinline__ void operator()(const f32x4 (&acc)[2][2][4][2], const Unit& u, int wr, int wc, int fr, int fq) const {
        const int col0 = u.pn * BM + wc * 32 + 8 * fq;
        const __amdgpu_buffer_rsrc_t rsrc = __builtin_amdgcn_make_buffer_rsrc(PART, 0, 11 * MCTX * DM * 2, 0x00020000);
        f32x4 gv[2][2];
#pragma unroll
        for (int bj = 0; bj < 2; ++bj)
#pragma unroll
            for (int n = 0; n < 2; ++n) gv[bj][n] = *(const f32x4*)(gate + (size_t)NB * MODLD + col0 + bj * HALF + n * 4) * coef;
#pragma unroll
        for (int ai = 0; ai < 2; ++ai)
#pragma unroll
            for (int m = 0; m < 4; ++m) { const unsigned rowo = (unsigned)(((size_t)u.ks * MCTX + (u.pm * BM + ai * HALF + wr * 64 + m * 16 + fr)) * DM + col0) * 2u;
#pragma unroll
                for (int bj = 0; bj < 2; ++bj) { const f32x4 v0 = gv[bj][0] * acc[ai][bj][m][0], v1 = gv[bj][1] * acc[ai][bj][m][1];
                    u32x4 w; w.x = cvt_pk_bf16(v0[0], v0[1]); w.y = cvt_pk_bf16(v0[2], v0[3]); w.z = cvt_pk_bf16(v1[0], v1[1]); w.w = cvt_pk_bf16(v1[2], v1[3]);
                    __builtin_amdgcn_raw_buffer_store_b128(w, rsrc, rowo + bj * HALF * 2, 0, 16); } }
    }
};
template <int MODE, bool BBF> struct EpiResidNorm {
    static constexpr bool PERM = true, AFTER_DRAIN = true;
    const float* base; float* out; const float* gate; float coef; const float* g; const float* shift; const float* scale; bf16_t* XN; float* xbuf; unsigned* cnt; bf16_t* XB;
    __device__ __forceinline__ void fused(f32x4 (&acc)[2][2][4][2], const Unit& u, int wr, int wc, int fr, int fq, LAS unsigned char* lds, int tid) const {
        const float* base = this->base; float* out = this->out; const float* gate = this->gate; const float* g = this->g; const float* shift = this->shift; const float* scale = this->scale;
        bf16_t* XN = this->XN; float* xbuf = this->xbuf; unsigned* cnt = this->cnt; float coef = this->coef; bf16_t* XB = this->XB;
        asm volatile("" : "+s"(base), "+s"(out), "+s"(gate), "+s"(g), "+s"(shift), "+s"(scale), "+s"(XN), "+s"(xbuf), "+s"(cnt), "+s"(coef), "+s"(XB));
        bf16_t* xb_ = XB + (size_t)u.pm * BM * DM;
        const int cls = u.pm / (SEQ / BM);
        const float* bs_ = base + (size_t)u.pm * BM * DM; float* out_ = out + (size_t)u.pm * BM * DM;
        const int col0 = u.pn * BM + wc * 32 + 8 * fq;
        LAS float* P = (LAS float*)lds;
        LAS float* S = (LAS float*)(lds + 4096);
        {
            f32x4 gv[2][2];
#pragma unroll
            for (int bj = 0; bj < 2; ++bj)
#pragma unroll
                for (int n = 0; n < 2; ++n) gv[bj][n] = *(const f32x4*)(gate + (size_t)cls * MODLD + col0 + bj * HALF + n * 4) * coef;
#pragma unroll
            for (int ai = 0; ai < 2; ++ai)
#pragma unroll
                for (int m = 0; m < 4; ++m) { const size_t off = (size_t)(ai * HALF + wr * 64 + m * 16 + fr) * DM + col0; float q = 0.f;
#pragma unroll
                    for (int bj = 0; bj < 2; ++bj) { f32x4 b0, b1;
                        if (BBF) { const u32x4 w = *(const u32x4*)(xb_ + off + bj * HALF);
                            b0 = (f32x4){__uint_as_float(w.x << 16), __uint_as_float(w.x & 0xffff0000u), __uint_as_float(w.y << 16), __uint_as_float(w.y & 0xffff0000u)};
                            b1 = (f32x4){__uint_as_float(w.z << 16), __uint_as_float(w.z & 0xffff0000u), __uint_as_float(w.w << 16), __uint_as_float(w.w & 0xffff0000u)}; }
                        else { b0 = *(const f32x4*)(bs_ + off + bj * HALF); b1 = *(const f32x4*)(bs_ + off + bj * HALF + 4); }
                        const f32x4 x0 = b0 + gv[bj][0] * acc[ai][bj][m][0], x1 = b1 + gv[bj][1] * acc[ai][bj][m][1]; acc[ai][bj][m][0] = x0; acc[ai][bj][m][1] = x1;
                        q += ((x0[0] * x0[0] + x0[1] * x0[1]) + (x0[2] * x0[2] + x0[3] * x0[3])) + ((x1[0] * x1[0] + x1[1] * x1[1]) + (x1[2] * x1[2] + x1[3] * x1[3])); }
                    q += __shfl_xor(q, 16); q += __shfl_xor(q, 32);
                    if (fq == 0) P[(ai * HALF + wr * 64 + m * 16 + fr) * 4 + wc] = q;
                    asm volatile("" ::: "memory"); }
        }
        asm volatile("s_waitcnt lgkmcnt(0)" ::: "memory"); __builtin_amdgcn_s_barrier(); asm volatile("" ::: "memory");
        if (tid < 256) { const float t_ = (P[tid * 4 + 0] + P[tid * 4 + 1]) + (P[tid * 4 + 2] + P[tid * 4 + 3]);
            __hip_atomic_store(xbuf + ((size_t)u.pm * BM + tid) * 4 + u.pn, t_, __ATOMIC_RELAXED, __HIP_MEMORY_SCOPE_AGENT); }
        asm volatile("s_waitcnt vmcnt(0)" ::: "memory"); __builtin_amdgcn_s_barrier(); asm volatile("" ::: "memory");
        if (tid == 0) { __hip_atomic_fetch_add(cnt + u.pm, 1u, __ATOMIC_RELAXED, __HIP_MEMORY_SCOPE_AGENT);
            unsigned sp = 0; while (__hip_atomic_load(cnt + u.pm, __ATOMIC_RELAXED, __HIP_MEMORY_SCOPE_AGENT) < 4u) { __builtin_amdgcn_s_sleep(1); if (++sp > (1u << 24)) break; }
            __builtin_amdgcn_fence(__ATOMIC_ACQUIRE, "agent"); asm volatile("s_waitcnt vmcnt(0)" ::: "memory"); }
        __builtin_amdgcn_s_barrier(); asm volatile("" ::: "memory");
        if (tid < 256) { const float* sl = xbuf + ((size_t)u.pm * BM + tid) * 4; float t_ = 0.f;
#pragma unroll
            for (int k = 0; k < 4; ++k) t_ += __hip_atomic_load(sl + k, __ATOMIC_RELAXED, __HIP_MEMORY_SCOPE_AGENT);
            S[tid] = 1.0f / sqrtf(t_ * (1.0f / DM) + RMS_EPS); }
        asm volatile("s_waitcnt lgkmcnt(0)" ::: "memory"); __builtin_amdgcn_s_barrier(); asm volatile("" ::: "memory");
#pragma unroll
        for (int bj = 0; bj < 2; ++bj) { const int c = col0 + bj * HALF;
            const f32x4 g0 = *(const f32x4*)(g + c), g1 = *(const f32x4*)(g + c + 4);
            f32x4 sc0 = {0.f, 0.f, 0.f, 0.f}, sc1 = sc0, sh0 = sc0, sh1 = sc0;
            if (MODE == 0) { sc0 = *(const f32x4*)(scale + (size_t)cls * MODLD + c) + 1.0f; sc1 = *(const f32x4*)(scale + (size_t)cls * MODLD + c + 4) + 1.0f;
                sh0 = *(const f32x4*)(shift + (size_t)cls * MODLD + c); sh1 = *(const f32x4*)(shift + (size_t)cls * MODLD + c + 4); }
#pragma unroll
            for (int ai = 0; ai < 2; ++ai)
#pragma unroll
                for (int m = 0; m < 4; ++m) { const int r = ai * HALF + wr * 64 + m * 16 + fr; const size_t off = (size_t)r * DM + c; const float rs = S[r];
                    const f32x4 x0 = acc[ai][bj][m][0], x1 = acc[ai][bj][m][1]; const f32x4 y0 = x0 * rs * g0, y1 = x1 * rs * g1;
                    if (MODE == 0) { { u32x4 wx; wx.x = cvt_pk_bf16(x0[0], x0[1]); wx.y = cvt_pk_bf16(x0[2], x0[3]); wx.z = cvt_pk_bf16(x1[0], x1[1]); wx.w = cvt_pk_bf16(x1[2], x1[3]); *(u32x4*)(xb_ + off) = wx; }
                        const f32x4 z0 = y0 * sc0 + sh0, z1 = y1 * sc1 + sh1;
                        u32x4 w; w.x = cvt_pk_bf16(z0[0], z0[1]); w.y = cvt_pk_bf16(z0[2], z0[3]); w.z = cvt_pk_bf16(z1[0], z1[1]); w.w = cvt_pk_bf16(z1[2], z1[3]);
                        *(u32x4*)(XN + (size_t)u.pm * BM * DM + off) = w; }
                    else { *(f32x4*)(out_ + off) = y0; *(f32x4*)(out_ + off + 4) = y1; } }
            asm volatile("" ::: "memory"); }
        asm volatile("s_waitcnt lgkmcnt(0)" ::: "memory"); __builtin_amdgcn_s_barrier(); asm volatile("" ::: "memory");
    }
};
struct EpiInProj {
    static constexpr bool PERM = true, AFTER_DRAIN = false;
    bf16_t* Q; bf16_t* Kb; bf16_t* VT; bf16_t* DFTB; const float* ropec; const float* ropes; unsigned* nmax;
    __device__ __forceinline__ void operator()(const f32x4 (&acc)[2][2][4][2], const Unit& u, int wr, int wc, int fr, int fq) const {
        if (u.kind <= 1) {
            bf16_t* dst = u.kind == 0 ? Q : Kb; const float sc = u.kind == 0 ? QSCALE : 1.0f;
            const int axis = wc & 1, pb = 8 * (fq & 1); const bool upper = fq >= 2; float gmax = 0.f;
#pragma unroll
            for (int ai = 0; ai < 2; ++ai)
#pragma unroll
                for (int m = 0; m < 4; ++m) {
                    const int row = u.pm * BM + ai * HALF + wr * 64 + m * 16 + fr;
                    const bool lat = row < MLAT; const int t = row & (SEQ - 1); const int pos = axis ? (t & 63) : (t >> 6);
                    f32x4 c0 = *(const f32x4*)(ropec + pos * 16 + pb), c1 = *(const f32x4*)(ropec + pos * 16 + pb + 4), s0 = *(const f32x4*)(ropes + pos * 16 + pb), s1 = *(const f32x4*)(ropes + pos * 16 + pb + 4);
                    if (!lat) { c0 = (f32x4){1.f, 1.f, 1.f, 1.f}; c1 = c0; s0 = (f32x4){0.f, 0.f, 0.f, 0.f}; s1 = s0; }
                    if (!upper) { s0 = -s0; s1 = -s1; }
                    bf16_t* rowp = dst + (size_t)row * DQK + u.pn * BM + wc * 32 + 8 * fq;
#pragma unroll
                    for (int bj = 0; bj < 2; ++bj) { const f32x4 a0 = acc[ai][bj][m][0], a1 = acc[ai][bj][m][1]; f32x4 p0, p1;
#pragma unroll
                        for (int i = 0; i < 4; ++i) {
                            auto r0 = __builtin_amdgcn_permlane32_swap(__float_as_uint(a0[i]), __float_as_uint(a0[i]), false, false); p0[i] = __uint_as_float(upper ? r0[0] : r0[1]);
                            auto r1 = __builtin_amdgcn_permlane32_swap(__float_as_uint(a1[i]), __float_as_uint(a1[i]), false, false); p1[i] = __uint_as_float(upper ? r1[0] : r1[1]); }
                        const f32x4 o0 = (a0 * c0 + p0 * s0) * sc, o1 = (a1 * c1 + p1 * s1) * sc;
                        { float ss = ((o0[0] * o0[0] + o0[1] * o0[1]) + (o0[2] * o0[2] + o0[3] * o0[3])) + ((o1[0] * o1[0] + o1[1] * o1[1]) + (o1[2] * o1[2] + o1[3] * o1[3]));
                          ss += __shfl_xor(ss, 16); ss += __shfl_xor(ss, 32); gmax = fmaxf(gmax, ss); }
                        u32x4 w; w.x = cvt_pk_bf16(o0[0], o0[1]); w.y = cvt_pk_bf16(o0[2], o0[3]); w.z = cvt_pk_bf16(o1[0], o1[1]); w.w = cvt_pk_bf16(o1[2], o1[3]);
                        *(u32x4*)(rowp + bj * HALF) = w; }
                }
#pragma unroll
            for (int o = 1; o < 16; o <<= 1) gmax = fmaxf(gmax, __shfl_xor(gmax, o));
            if ((fr | fq) == 0) atomicMax(nmax + u.kind * 64 + ((u.pm * 8 + wr * 4 + wc) & 63), __float_as_uint(gmax));
        } else {
            bf16_t* base; size_t ld;
            if (u.kind == 2) { base = VT + (size_t)u.pm * BM * MALL + (size_t)u.pn * BM; ld = MALL; }
            else {
                const int b = u.pn >> 4, j = u.pn & 15; base = DFTB + ((size_t)(b * 256) * 64 + 4 * j) * 128 + (size_t)u.pm * 64; ld = 64 * 128; }
#pragma unroll
            for (int ai = 0; ai < 2; ++ai)
#pragma unroll
                for (int m = 0; m < 4; ++m) { bf16_t* rowp = base + (size_t)(ai * HALF + wr * 64 + m * 16 + fr) * ld + (u.kind == 2 ? wc * 32 : (wc >> 1) * 128 + (wc & 1) * 32) + 8 * fq;
#pragma unroll
                    for (int bj = 0; bj < 2; ++bj) { const f32x4 v0 = acc[ai][bj][m][0], v1 = acc[ai][bj][m][1];
                        u32x4 w; w.x = cvt_pk_bf16(v0[0], v0[1]); w.y = cvt_pk_bf16(v0[2], v0[3]); w.z = cvt_pk_bf16(v1[0], v1[1]); w.w = cvt_pk_bf16(v1[2], v1[3]);
                        *(u32x4*)(rowp + (u.kind == 2 ? bj * HALF : bj * 256)) = w; } }
        }
    }
};
struct EpiFFT1 {
    static constexpr bool PERM = true, AFTER_DRAIN = false;
    bf16_t* YT; const f32x2* TW;
    __device__ __forceinline__ void operator()(const f32x4 (&acc)[2][2][4][2], const Unit& u, int wr, int wc, int fr, int fq) const {
        if (wr != 0) return;
        const __amdgpu_buffer_rsrc_t rsrc = __builtin_amdgcn_make_buffer_rsrc(YT, 0, 65536 * 128 * 2, 0x00020000);
#pragma unroll
        for (int m = 0; m < 4; ++m) { const int k1 = 16 * m + fr;
#pragma unroll
            for (int bj = 0; bj < 2; ++bj) { const int col = 4 * u.pn + 2 * bj + (wc >> 1), b = col >> 8, ch = col & 255;
                const int n2 = 32 * (wc & 1) + 8 * fq;
                const unsigned rowo = (unsigned)((((size_t)(b * 64 + k1) * 256 + ch) * 128 + n2) * 2);
                int kk = k1; asm volatile("" : "+v"(kk));
                f32x4 pr[2], pi[2];
#pragma unroll
                for (int n = 0; n < 2; ++n) { const f32x4 yr = acc[0][bj][m][n], yi = acc[1][bj][m][n];
#pragma unroll
                    for (int i = 0; i < 4; ++i) { const f32x2 cs = TW[(n2 + 4 * n + i) * kk]; pr[n][i] = yr[i] * cs.x + yi[i] * cs.y; pi[n][i] = yi[i] * cs.x - yr[i] * cs.y; } }
                u32x4 w; w.x = cvt_pk_bf16(pr[0][0], pr[0][1]); w.y = cvt_pk_bf16(pr[0][2], pr[0][3]); w.z = cvt_pk_bf16(pr[1][0], pr[1][1]); w.w = cvt_pk_bf16(pr[1][2], pr[1][3]);
                __builtin_amdgcn_raw_buffer_store_b128(w, rsrc, rowo, 0, 16);
                w.x = cvt_pk_bf16(pi[0][0], pi[0][1]); w.y = cvt_pk_bf16(pi[0][2], pi[0][3]); w.z = cvt_pk_bf16(pi[1][0], pi[1][1]); w.w = cvt_pk_bf16(pi[1][2], pi[1][3]);
                __builtin_amdgcn_raw_buffer_store_b128(w, rsrc, rowo + 128, 0, 16);
                asm volatile("" ::: "memory"); } }
    }
};
struct EpiFFT2 {
    static constexpr bool PERM = true, AFTER_DRAIN = false;
    bf16_t* AO;
    __device__ __forceinline__ void operator()(const f32x4 (&acc)[2][2][4][2], const Unit& u, int wr, int wc, int fr, int fq) const {
        if (wr != 0) return;
        const float sc = 1.0f / 512.0f; const int b = u.pn >> 6, k1 = u.pn & 63;
#pragma unroll
        for (int m = 0; m < 4; ++m) { const int k2 = 16 * m + fr; bf16_t* rowp = AO + (size_t)(b * SEQ + 64 * k2 + k1) * DM + DQK + wc * 32 + 8 * fq;
#pragma unroll
            for (int bj = 0; bj < 2; ++bj) { const f32x4 v0 = acc[0][bj][m][0] * sc, v1 = acc[0][bj][m][1] * sc;
                u32x4 w; w.x = cvt_pk_bf16(v0[0], v0[1]); w.y = cvt_pk_bf16(v0[2], v0[3]); w.z = cvt_pk_bf16(v1[0], v1[1]); w.w = cvt_pk_bf16(v1[2], v1[3]);
                *(u32x4*)(rowp + bj * HALF) = w; } }
    }
};
}

struct Args { const float* in[24]; float* out; unsigned char* ws; int ph_lo, ph_hi; };
enum { I_X = 0, I_C, I_CTX, I_CCTX, I_WADA, I_BADA, I_N1G, I_F1G, I_F1U, I_F1D, I_NMG, I_WIN, I_LQ1, I_LK1, I_LQ2, I_LK2, I_SUBG, I_WFOUR, I_WOUT, I_N2G, I_F2G, I_F2U, I_F2D, I_FNG };

__device__ __forceinline__ void wg_publish(unsigned* cnt);
__device__ __forceinline__ void wg_await(unsigned* cnt, unsigned want);
__device__ __forceinline__ unsigned f2bf(float f) { unsigned u = __builtin_bit_cast(unsigned, f); return (u + 0x7fffu + ((u >> 16) & 1u)) >> 16; }
__device__ __forceinline__ unsigned pk2(float lo, float hi) { return f2bf(lo) | (f2bf(hi) << 16); }

__device__ __forceinline__ void transpose_item(const float* W, int ldw, int k0, int nsrc0, bf16_t* WT, int ldt, int drow0, int dk0, LAS float* scr, int lane) {
#pragma unroll
    for (int i = 0; i < 8; ++i) { const int kk = 8 * i + (lane >> 3), c4 = lane & 7; const f32x4 v = __builtin_nontemporal_load((const f32x4*)(W + (size_t)(k0 + kk) * ldw + nsrc0 + 4 * c4));
        scr[kk * 33 + 4 * c4] = v[0]; scr[kk * 33 + 4 * c4 + 1] = v[1]; scr[kk * 33 + 4 * c4 + 2] = v[2]; scr[kk * 33 + 4 * c4 + 3] = v[3]; }
    asm volatile("s_waitcnt lgkmcnt(0)" ::: "memory");
    const int c = lane & 7;
#pragma unroll
    for (int j = 0; j < 4; ++j) { const int n = (lane >> 3) + 8 * j; const LAS float* s = scr + (8 * c) * 33 + n;
        u32x4 o; o.x = pk2(s[0 * 33], s[1 * 33]); o.y = pk2(s[2 * 33], s[3 * 33]); o.z = pk2(s[4 * 33], s[5 * 33]); o.w = pk2(s[6 * 33], s[7 * 33]);
        *(u32x4*)(WT + (size_t)(drow0 + n) * ldt + dk0 + k0 + 8 * c) = o; }
    asm volatile("s_waitcnt lgkmcnt(0)" ::: "memory");
}

__device__ __forceinline__ void weight_transposes(const Args& A, LAS unsigned char* lds, int wk, int nwk, const int tid, const int stage) {
    const int lane = tid & 63, wave = __builtin_amdgcn_readfirstlane(tid >> 6);
    unsigned char* ws = A.ws;
    LAS float* scr = (LAS float*)(lds + wave * 16384);
    const int gw = wk * 8 + wave, NGW = nwk * 8;
    constexpr int I_GU = 16 * 88, I_DN = 44 * 32, I_IN = 16 * 72, I_OUT = 12 * 32;
    const bool ffn2 = stage >= 2;
    const int n_gu = (stage == 0 || stage == 2) ? 2 * I_GU : 0, n_dn = (stage == 1 || stage == 3) ? I_DN : 0, n_x = stage == 1 ? I_IN : (stage == 4 ? I_OUT : 0);
    const int nit = n_gu + n_dn + n_x;
    for (int it = gw; it < nit; it += NGW) {
        int r = it;
        if (r < n_gu) {
            const int up = r / I_GU; r -= up * I_GU; const int kb = r / 88, nb = r % 88, n0 = nb * 32;
            const float* W = A.in[ffn2 ? (up ? I_F2U : I_F2G) : (up ? I_F1U : I_F1G)];
            bf16_t* WT = (bf16_t*)(ws + (ffn2 ? WS_WGU2 : WS_WGU1));
            transpose_item(W, DFF, kb * 64, n0, WT, DM, 256 * (n0 >> 7) + (n0 & 127) + (up ? 128 : 0), 0, scr, lane);
            continue;
        }
        r -= n_gu;
        if (r < n_dn) {
            const int kb = r / 32, nb = r % 32;
            transpose_item(A.in[ffn2 ? I_F2D : I_F1D], DM, kb * 64, nb * 32, (bf16_t*)(ws + (ffn2 ? WS_WD2 : WS_WD1)), DFF, nb * 32, 0, scr, lane);
            continue;
        }
        r -= n_dn;
        if (!ffn2) { const int kb = r / 72, nb = r % 72; transpose_item(A.in[I_WIN], 2560, kb * 64, nb * 32, (bf16_t*)(ws + WS_WIN), DM, nb * 32, 0, scr, lane); }
        else { const int kb = r / 32, nb = r % 32; transpose_item(A.in[I_WOUT], DM, kb * 64, nb * 32, (bf16_t*)(ws + WS_WO), DM, nb * 32, 0, scr, lane); }
    }
}

__device__ __forceinline__ void prologue(const Args& A, LAS unsigned char* lds, int vcu, int G, const int tid) {
    const int lane = tid & 63, wave = __builtin_amdgcn_readfirstlane(tid >> 6);
    unsigned char* ws = A.ws;
    const int vf = vcu - (G - 3);
    if (vf == 0 || vf == 1) {
        bf16_t* Mx = (bf16_t*)(ws + (vf == 0 ? WS_M1 : WS_M2));
        for (int i = tid; i < 256 * 128; i += 512) { const int r = i >> 7, kap = i & 127, part = kap >> 6, nn = kap & 63; float v = 0.f;
            if (vf == 0) { if (r < 64) { const float ph = (float)((r * nn) & 63) * (1.0f / 32.0f); v = part == 0 ? cospif(ph) : -sinpif(ph); }
                            else if (r >= 128 && r < 192) { const float ph = (float)(((r - 128) * nn) & 63) * (1.0f / 32.0f); v = part == 0 ? -sinpif(ph) : -cospif(ph); } }
            else { if (r < 64) { const float ph = (float)((r * nn) & 63) * (1.0f / 32.0f); v = part == 0 ? cospif(ph) : sinpif(ph); } }
            Mx[i] = (bf16_t)f2bf(v); }
    } else if (vf == 2) {
        f32x2* TW = (f32x2*)(ws + WS_TW);
        for (int i = tid; i < 4096; i += 512) { const float ph = (float)i * (1.0f / 2048.0f); TW[i] = (f32x2){cospif(ph), sinpif(ph)}; }
    }
    for (int it = vcu; it < 257; it += G) {
        if (it < 128) {
            LAS float* sc = (LAS float*)lds;
            LAS float* red = (LAS float*)(lds + 5 * 1024 * 4);
            for (int i = tid; i < 5 * 1024; i += 512) { const int r = i >> 10, k = i & 1023; const float cv = r < 4 ? A.in[I_C][r * 1024 + k] : A.in[I_CCTX][k]; sc[i] = cv / (1.0f + expf(-cv)); }
            __syncthreads();
            const int n0 = it * 72, c4 = tid % 18, kg = tid / 18;
            f32x4 a0 = {0.f, 0.f, 0.f, 0.f}, a1 = a0, a2 = a0, a3 = a0, a4 = a0;
            if (kg < 28) {
                const float* wp = A.in[I_WADA] + n0 + 4 * c4;
#pragma unroll 8
                for (int kk = 0; kk < 37; ++kk) { const int k = kg + 28 * kk; if (k < 1024) { const f32x4 w = __builtin_nontemporal_load((const f32x4*)(wp + (size_t)k * MODLD));
                    a0 += w * sc[k]; a1 += w * sc[1024 + k]; a2 += w * sc[2048 + k]; a3 += w * sc[3072 + k]; a4 += w * sc[4096 + k]; } }
                *(LAS f32x4*)(red + (0 * 28 + kg) * 72 + 4 * c4) = a0; *(LAS f32x4*)(red + (1 * 28 + kg) * 72 + 4 * c4) = a1; *(LAS f32x4*)(red + (2 * 28 + kg) * 72 + 4 * c4) = a2;
                *(LAS f32x4*)(red + (3 * 28 + kg) * 72 + 4 * c4) = a3; *(LAS f32x4*)(red + (4 * 28 + kg) * 72 + 4 * c4) = a4; }
            __syncthreads();
            if (tid < 360) { const int r = tid / 72, n = tid % 72; float s_ = A.in[I_BADA][n0 + n];
                for (int q = 0; q < 28; ++q) s_ += red[(r * 28 + q) * 72 + n];
                __hip_atomic_store((float*)(ws + WS_MOD) + r * MODLD + n0 + n, s_, __ATOMIC_RELAXED, __HIP_MEMORY_SCOPE_AGENT); }
            wg_publish((unsigned*)(ws + WS_BAR) + 3856);
            __syncthreads();
        } else if (it < 192) {
            const int item = it - 128, k0 = (item >> 2) * 64, g = item & 3;
            LAS float* wt = (LAS float*)lds;
            LAS float* tab = (LAS float*)(lds + 64 * 65 * 4);
            for (int i = tid; i < 4096; i += 512) { const int kk = i >> 6, d = i & 63; wt[kk * 65 + d] = A.in[I_WIN][(size_t)(k0 + kk) * 2560 + 2304 + g * 64 + d]; }
            if (tid < 64) tab[tid] = cospif((float)tid * (1.0f / 32.0f));
            __syncthreads();
            const int kk = tid & 63, grp = tid >> 6;
            bf16_t* WF = (bf16_t*)(ws + WS_WF);
            for (int jj = 0; jj < 16; ++jj) {
                const int e = grp * 16 + jj, part = e >> 6, dp = e & 63, add = part ? 48 : 0;
                float s_ = 0.f;
#pragma unroll 8
                for (int d = 0; d < 64; ++d) s_ += wt[kk * 65 + d] * tab[(d * dp + add) & 63];
                WF[(size_t)(part * 256 + g * 64 + dp) * DM + k0 + kk] = (bf16_t)f2bf(s_);
            }
            __syncthreads();
        } else if (it < 256) {
            const int item = it - 192, n0 = (item >> 2) * 64, j0 = (item & 3) * 64;
            LAS float* wo = (LAS float*)lds;
            LAS float* wfl = (LAS float*)(lds + 65536);
            for (int i = tid; i < 256 * 64; i += 512) { const int ii = i >> 6, n = i & 63; wo[i] = A.in[I_WOUT][(size_t)(768 + ii) * DM + n0 + n]; }
            for (int i = tid; i < 64 * 256; i += 512) wfl[i] = A.in[I_WFOUR][(size_t)j0 * 256 + i];
            __syncthreads();
            bf16_t* WO = (bf16_t*)(ws + WS_WO);
            float acc[8];
#pragma unroll
            for (int q = 0; q < 8; ++q) acc[q] = 0.f;
#pragma unroll 4
            for (int i = 0; i < 256; ++i) { const float w = wo[i * 64 + lane];
#pragma unroll
                for (int q = 0; q < 8; ++q) acc[q] += wfl[(wave * 8 + q) * 256 + i] * w; }
#pragma unroll
            for (int q = 0; q < 8; ++q) WO[(size_t)(n0 + lane) * DM + 768 + j0 + wave * 8 + q] = (bf16_t)f2bf(acc[q]);
            __syncthreads();
        } else {
            float* rc = (float*)(ws + WS_ROPE); float* rs = rc + 1024;
            for (int i = tid; i < 1024; i += 512) { const int pos = i >> 4, p = i & 15; const float inv = powf(10000.0f, -(float)p / 16.0f); const float ang = (float)pos * inv; rc[i] = cosf(ang); rs[i] = sinf(ang); }
            if (wave == 0) {
                const float d1 = wave_sum(A.in[I_LQ1][lane] * A.in[I_LK1][lane]), d2 = wave_sum(A.in[I_LQ2][lane] * A.in[I_LK2][lane]);
                if (lane == 0) ((float*)(ws + WS_SCAL))[0] = expf(d1) - expf(d2) + LAMBDA_INIT;
            }
        }
    }
    __syncthreads();
    weight_transposes(A, lds, vcu, G, tid, 0);
}

template <bool MOD>
__device__ __forceinline__ void rownorm1(const float* xrow, const bf16_t* part, const float* g, const float* shift, const float* scale, bf16_t* obf, float* of32, int lane) {
    f32x4 v[4]; float ss = 0.f;
#pragma unroll
    for (int j = 0; j < 4; ++j) { v[j] = ((const f32x4*)xrow)[lane + 64 * j]; if (part) {
            for (int ks = 0; ks < 11; ++ks) { const u32x2 w = ((const u32x2*)(part + (size_t)ks * MCTX * DM))[lane + 64 * j];
                v[j][0] += __uint_as_float(w.x << 16); v[j][1] += __uint_as_float(w.x & 0xffff0000u); v[j][2] += __uint_as_float(w.y << 16); v[j][3] += __uint_as_float(w.y & 0xffff0000u); } }
        ss += (v[j][0] * v[j][0] + v[j][1] * v[j][1]) + (v[j][2] * v[j][2] + v[j][3] * v[j][3]); }
    const float rstd = 1.0f / sqrtf(wave_sum(ss) * (1.0f / DM) + RMS_EPS);
#pragma unroll
    for (int j = 0; j < 4; ++j) {
        const f32x4 gv = ((const f32x4*)g)[lane + 64 * j];
        f32x4 y = v[j] * rstd * gv;
        if (MOD) { const f32x4 sh = ((const f32x4*)shift)[lane + 64 * j], sc = ((const f32x4*)scale)[lane + 64 * j]; y = y * (sc + 1.0f) + sh;
            u32x2 w; w.x = cvt_pk_bf16(y[0], y[1]); w.y = cvt_pk_bf16(y[2], y[3]); ((u32x2*)obf)[lane + 64 * j] = w; }
        else ((f32x4*)of32)[lane + 64 * j] = y;
    }
}

template <bool MOD>
__device__ __forceinline__ void rownorm2(const float* xa, const float* xb, const float* g, const float* sha, const float* sca, const float* shb, const float* scb, bf16_t* oa, bf16_t* ob, float* fa, float* fb, int lane) {
    f32x4 va[4], vb[4]; float sa = 0.f, sb = 0.f;
#pragma unroll
    for (int j = 0; j < 4; ++j) { const int ix = 128 * (j >> 1) + 2 * lane + (j & 1); va[j] = ((const f32x4*)xa)[ix]; vb[j] = ((const f32x4*)xb)[ix]; }
#pragma unroll
    for (int j = 0; j < 4; ++j) { sa += (va[j][0] * va[j][0] + va[j][1] * va[j][1]) + (va[j][2] * va[j][2] + va[j][3] * va[j][3]); sb += (vb[j][0] * vb[j][0] + vb[j][1] * vb[j][1]) + (vb[j][2] * vb[j][2] + vb[j][3] * vb[j][3]); }
#pragma unroll
    for (int o = 1; o < 64; o <<= 1) { sa += __shfl_xor(sa, o); sb += __shfl_xor(sb, o); }
    const float ra = 1.0f / sqrtf(sa * (1.0f / DM) + RMS_EPS), rb = 1.0f / sqrtf(sb * (1.0f / DM) + RMS_EPS);
#pragma unroll
    for (int j2 = 0; j2 < 2; ++j2) {
        f32x4 ya[2], yb[2];
#pragma unroll
        for (int h = 0; h < 2; ++h) { const int ix = 128 * j2 + 2 * lane + h; const f32x4 gv = ((const f32x4*)g)[ix];
            ya[h] = va[2 * j2 + h] * ra * gv; yb[h] = vb[2 * j2 + h] * rb * gv;
            if (MOD) { ya[h] = ya[h] * (((const f32x4*)sca)[ix] + 1.0f) + ((const f32x4*)sha)[ix]; yb[h] = yb[h] * (((const f32x4*)scb)[ix] + 1.0f) + ((const f32x4*)shb)[ix]; }
            else { ((f32x4*)fa)[ix] = ya[h]; ((f32x4*)fb)[ix] = yb[h]; } }
        if (MOD) { u32x4 w; w.x = cvt_pk_bf16(ya[0][0], ya[0][1]); w.y = cvt_pk_bf16(ya[0][2], ya[0][3]); w.z = cvt_pk_bf16(ya[1][0], ya[1][1]); w.w = cvt_pk_bf16(ya[1][2], ya[1][3]); ((u32x4*)oa)[64 * j2 + lane] = w;
            w.x = cvt_pk_bf16(yb[0][0], yb[0][1]); w.y = cvt_pk_bf16(yb[0][2], yb[0][3]); w.z = cvt_pk_bf16(yb[1][0], yb[1][1]); w.w = cvt_pk_bf16(yb[1][2], yb[1][3]); ((u32x4*)ob)[64 * j2 + lane] = w; }
    }
}

constexpr int AT_KSLOT = 16384, AT_VSLOT = 16384, AT_VBASE = 3 * AT_KSLOT;
__device__ __forceinline__ int at_tok0(int b, int t) { return t < 64 ? b * SEQ + 64 * t : MLAT + b * CTXL + 64 * (t - 64); }
__device__ __forceinline__ float max3f(float a, float b, float c) { float r; asm("v_max3_f32 %0, %1, %2, %3" : "=v"(r) : "v"(a), "v"(b), "v"(c)); return r; }
__device__ __forceinline__ float xhalf_max(float v) { auto rr = __builtin_amdgcn_permlane32_swap(__float_as_uint(v), __float_as_uint(v), false, false); return max3f(__uint_as_float(rr[0]), __uint_as_float(rr[1]), v); }
__device__ __forceinline__ float xhalf_sum(float v) { auto rr = __builtin_amdgcn_permlane32_swap(__float_as_uint(v), __float_as_uint(v), false, false); return __uint_as_float(rr[0]) + __uint_as_float(rr[1]); }

__device__ __forceinline__ void attn_phase(const Args& A, LAS unsigned char* lds, int vcu, int G, const int tid) {
    const int lane = tid & 63, r32 = lane & 31, hi = lane >> 5, wid = __builtin_amdgcn_readfirstlane(tid >> 6), qi = wid & 3, c = wid >> 2;
    const bf16_t* Q = (const bf16_t*)(A.ws + WS_Q); const char* Kg = (const char*)(A.ws + WS_K); const char* VT = (const char*)(A.ws + WS_VT);
    bf16_t* AO = (bf16_t*)(A.ws + WS_AO);
    const float lam = ((const float*)(A.ws + WS_SCAL))[0];
    constexpr int NT = 68;
    bool fast; { const unsigned* nm = (const unsigned*)(A.ws + WS_BAR) + 3456; unsigned mq = nm[lane], mk = nm[64 + lane];
#pragma unroll
        for (int o_ = 1; o_ < 64; o_ <<= 1) { const unsigned a_ = __shfl_xor(mq, o_), b_ = __shfl_xor(mk, o_); mq = a_ > mq ? a_ : mq; mk = b_ > mk ? b_ : mk; }
        const float qn = sqrtf(__uint_as_float(mq)), kn = sqrtf(__uint_as_float(mk));
        fast = __builtin_amdgcn_readfirstlane((int)(2.0f * qn * kn * 1.03f < 96.0f)) != 0; }
    unsigned kso[2], vso[2];
#pragma unroll
    for (int i = 0; i < 2; ++i) {
        const int p = 2 * wid + i;
        { const int row = 4 * p + (lane >> 4), cp = lane & 15, cg_ = cp ^ (row & 15); kso[i] = (unsigned)(row * (DQK * 2) + cg_ * 16); }
        { const int row = 8 * p + (lane >> 3), cp = lane & 7, cg_ = cp ^ ((row >> 1) & 7); vso[i] = (unsigned)(row * (MALL * 2) + cg_ * 16); }
    }
    const int pi_r = (r32 & 0x13) | ((r32 & 4) << 1) | ((r32 & 8) >> 1);
    const int kad0 = pi_r * 256 + (((8 * c + hi) ^ (pi_r & 15)) * 16), vad0 = r32 * 128 + ((hi ^ ((r32 >> 1) & 7)) * 16);
#define AT_DMAK(t_, slot_) do { const char* kb_ = Kg + (size_t)at_tok0(b, (t_)) * (DQK * 2) + h * 256; LAS unsigned char* sl_ = lds + (slot_) * AT_KSLOT; \
        __builtin_amdgcn_global_load_lds((const unsigned*)(kb_ + kso[0]), (LAS unsigned*)(sl_ + (2 * wid) * 1024), 16, 0, 0); \
        __builtin_amdgcn_global_load_lds((const unsigned*)(kb_ + kso[1]), (LAS unsigned*)(sl_ + (2 * wid + 1) * 1024), 16, 0, 0); } while (0)
#define AT_DMAV(t_, slot_) do { const char* vb_ = VT + (size_t)(h * 128) * (MALL * 2) + (size_t)at_tok0(b, (t_)) * 2; LAS unsigned char* sl_ = lds + AT_VBASE + (slot_) * AT_VSLOT; \
        __builtin_amdgcn_global_load_lds((const unsigned*)(vb_ + vso[0]), (LAS unsigned*)(sl_ + (2 * wid) * 1024), 16, 0, 0); \
        __builtin_amdgcn_global_load_lds((const unsigned*)(vb_ + vso[1]), (LAS unsigned*)(sl_ + (2 * wid + 1) * 1024), 16, 0, 0); } while (0)
#define SBAR() __builtin_amdgcn_sched_barrier(0)
#define EXG(S, e, F) do { f32x4 x_ = (f32x4){S[4 * (e)], S[4 * (e) + 1], S[4 * (e) + 2], S[4 * (e) + 3]}; if (!(F)) x_ = x_ - mrow; \
        S[4 * (e)] = __builtin_amdgcn_exp2f(x_[0]); S[4 * (e) + 1] = __builtin_amdgcn_exp2f(x_[1]); S[4 * (e) + 2] = __builtin_amdgcn_exp2f(x_[2]); S[4 * (e) + 3] = __builtin_amdgcn_exp2f(x_[3]); } while (0)
#define KFR(g) (*(const LAS bf16x8*)(bufK + (kadl ^ (((g) >> 1) * 32)) + ((g) & 1) * 32 * 256))
#define VFR(g) (*(const LAS bf16x8*)(bufV + (vadl ^ (((g) >> 2) * 32)) + ((g) & 3) * 32 * 128))
#define PACK(S, q) ({ u32x4 w_; w_.x = cvt_pk_bf16(S[8 * (q)], S[8 * (q) + 1]); w_.y = cvt_pk_bf16(S[8 * (q) + 2], S[8 * (q) + 3]); w_.z = cvt_pk_bf16(S[8 * (q) + 4], S[8 * (q) + 5]); w_.w = cvt_pk_bf16(S[8 * (q) + 6], S[8 * (q) + 7]); __builtin_bit_cast(bf16x8, w_); })
#define SUM4(S, e) do { ps[0] += S[4 * (e)]; ps[1] += S[4 * (e) + 1]; ps[2] += S[4 * (e) + 2]; ps[3] += S[4 * (e) + 3]; asm volatile("" : "+v"(ps)); } while (0)
#define AT_STEP_A(C0, C1, N0, N1, t_, FAST_) do { \
            if ((t_) + 3 < NT) AT_DMAK((t_) + 3, k0s); if ((t_) + 2 < NT) AT_DMAV((t_) + 2, ((t_) + 2) & 3); \
            const LAS unsigned char* bufK = lds + (k0s == 2 ? 0 : k0s + 1) * AT_KSLOT; int kadl = kad0, vadl = vad0; asm volatile("" : "+v"(kadl), "+v"(vadl)); \
            const LAS unsigned char* bufV = lds + AT_VBASE + ((t_) & 3) * AT_VSLOT; \
            bf16x8 f0 = KFR(0), f1 = KFR(1), f2 = KFR(2), f3 = KFR(3); \
            if (!(FAST_)) { float ma = max3f(C0[0], C0[1], C1[0]), mb = max3f(C0[2], C0[3], C1[1]); ma = max3f(ma, C1[2], C1[3]); \
            _Pragma("unroll") for (int r = 4; r < 16; r += 4) { ma = max3f(ma, C0[r], C0[r + 1]); mb = max3f(mb, C0[r + 2], C0[r + 3]); ma = max3f(ma, C1[r], C1[r + 1]); mb = max3f(mb, C1[r + 2], C1[r + 3]); } \
            const float mx = xhalf_max(max3f(ma, mb, mb)); \
            if (__any(mx > mrow)) { const float mn = max3f(mrow, mx, mx), al = __builtin_amdgcn_exp2f(mrow - mn); lrow *= al; mrow = mn; \
                _Pragma("unroll") for (int i = 0; i < 4; ++i) _Pragma("unroll") for (int r = 0; r < 16; ++r) o[i][r] *= al; } } \
            N0 = f32x16{}; N1 = f32x16{}; \
            N0 = __builtin_amdgcn_mfma_f32_32x32x16_bf16(f0, qf[0], N0, 0, 0, 0); f0 = KFR(4); EXG(C0, 0, FAST_); SBAR(); \
            N1 = __builtin_amdgcn_mfma_f32_32x32x16_bf16(f1, qf[0], N1, 0, 0, 0); f1 = KFR(5); EXG(C0, 1, FAST_); SBAR(); \
            N0 = __builtin_amdgcn_mfma_f32_32x32x16_bf16(f2, qf[1], N0, 0, 0, 0); f2 = KFR(6); EXG(C0, 2, FAST_); SBAR(); \
            N1 = __builtin_amdgcn_mfma_f32_32x32x16_bf16(f3, qf[1], N1, 0, 0, 0); f3 = KFR(7); EXG(C0, 3, FAST_); SBAR(); \
            N0 = __builtin_amdgcn_mfma_f32_32x32x16_bf16(f0, qf[2], N0, 0, 0, 0); f0 = VFR(0); EXG(C1, 0, FAST_); SBAR(); \
            N1 = __builtin_amdgcn_mfma_f32_32x32x16_bf16(f1, qf[2], N1, 0, 0, 0); f1 = VFR(1); EXG(C1, 1, FAST_); SBAR(); \
            N0 = __builtin_amdgcn_mfma_f32_32x32x16_bf16(f2, qf[3], N0, 0, 0, 0); f2 = VFR(2); EXG(C1, 2, FAST_); SBAR(); \
            N1 = __builtin_amdgcn_mfma_f32_32x32x16_bf16(f3, qf[3], N1, 0, 0, 0); f3 = VFR(3); EXG(C1, 3, FAST_); SBAR(); \
            f32x4 ps = (f32x4){0.f, 0.f, 0.f, 0.f}; bf16x8 p0 = PACK(C0, 0), p1, p2, p3; SBAR(); \
            o[0] = __builtin_amdgcn_mfma_f32_32x32x16_bf16(f0, p0, o[0], 0, 0, 0); f0 = VFR(4); p1 = PACK(C0, 1); SBAR(); \
            o[1] = __builtin_amdgcn_mfma_f32_32x32x16_bf16(f1, p0, o[1], 0, 0, 0); f1 = VFR(5); SUM4(C0, 0); SUM4(C0, 1); SBAR(); \
            o[2] = __builtin_amdgcn_mfma_f32_32x32x16_bf16(f2, p0, o[2], 0, 0, 0); f2 = VFR(6); SUM4(C0, 2); SUM4(C0, 3); SBAR(); \
            o[3] = __builtin_amdgcn_mfma_f32_32x32x16_bf16(f3, p0, o[3], 0, 0, 0); f3 = VFR(7);  SBAR(); \
            o[0] = __builtin_amdgcn_mfma_f32_32x32x16_bf16(f0, p1, o[0], 0, 0, 0); f0 = VFR(8); p2 = PACK(C1, 0); SBAR(); \
            o[1] = __builtin_amdgcn_mfma_f32_32x32x16_bf16(f1, p1, o[1], 0, 0, 0); f1 = VFR(9); SUM4(C1, 0); SUM4(C1, 1); SBAR(); \
            o[2] = __builtin_amdgcn_mfma_f32_32x32x16_bf16(f2, p1, o[2], 0, 0, 0); f2 = VFR(10); SUM4(C1, 2); SUM4(C1, 3); SBAR(); \
            o[3] = __builtin_amdgcn_mfma_f32_32x32x16_bf16(f3, p1, o[3], 0, 0, 0); f3 = VFR(11);  SBAR(); \
            o[0] = __builtin_amdgcn_mfma_f32_32x32x16_bf16(f0, p2, o[0], 0, 0, 0); f0 = VFR(12); p3 = PACK(C1, 1); SBAR(); \
            o[1] = __builtin_amdgcn_mfma_f32_32x32x16_bf16(f1, p2, o[1], 0, 0, 0); f1 = VFR(13);  SBAR(); \
            o[2] = __builtin_amdgcn_mfma_f32_32x32x16_bf16(f2, p2, o[2], 0, 0, 0); f2 = VFR(14);  SBAR(); \
            o[3] = __builtin_amdgcn_mfma_f32_32x32x16_bf16(f3, p2, o[3], 0, 0, 0); f3 = VFR(15);  SBAR(); \
            o[0] = __builtin_amdgcn_mfma_f32_32x32x16_bf16(f0, p3, o[0], 0, 0, 0);  SBAR(); \
            o[1] = __builtin_amdgcn_mfma_f32_32x32x16_bf16(f1, p3, o[1], 0, 0, 0);  SBAR(); \
            o[2] = __builtin_amdgcn_mfma_f32_32x32x16_bf16(f2, p3, o[2], 0, 0, 0);  SBAR(); \
            o[3] = __builtin_amdgcn_mfma_f32_32x32x16_bf16(f3, p3, o[3], 0, 0, 0);  SBAR(); \
            lrow += (ps[0] + ps[1]) + (ps[2] + ps[3]); \
            if ((t_) + 3 < NT) asm volatile("s_waitcnt vmcnt(4) lgkmcnt(0)" ::: "memory"); else if ((t_) + 2 < NT) asm volatile("s_waitcnt vmcnt(2) lgkmcnt(0)" ::: "memory"); else asm volatile("s_waitcnt vmcnt(0) lgkmcnt(0)" ::: "memory"); \
            __builtin_amdgcn_s_barrier(); asm volatile("" ::: "memory"); \
            k0s = k0s == 2 ? 0 : k0s + 1; } while (0)
#define AT_STEP_B(C0, C1, N0, N1, t_, FAST_) do { \
            if ((t_) + 3 < NT) AT_DMAK((t_) + 3, k0s); if ((t_) + 2 < NT) AT_DMAV((t_) + 2, ((t_) + 2) & 3); \
            const LAS unsigned char* bufK = lds + (k0s == 2 ? 0 : k0s + 1) * AT_KSLOT; int kadl = kad0, vadl = vad0; asm volatile("" : "+v"(kadl), "+v"(vadl)); \
            const LAS unsigned char* bufV = lds + AT_VBASE + (((t_) - 1) & 3) * AT_VSLOT; \
            bf16x8 f0 = VFR(0), f1 = VFR(1), f2 = VFR(2), f3 = VFR(3); \
            o[0] = __builtin_amdgcn_mfma_f32_32x32x16_bf16(f0, p0, o[0], 0, 0, 0); f0 = VFR(4);  SBAR(); \
            o[1] = __builtin_amdgcn_mfma_f32_32x32x16_bf16(f1, p0, o[1], 0, 0, 0); f1 = VFR(5);  SBAR(); \
            o[2] = __builtin_amdgcn_mfma_f32_32x32x16_bf16(f2, p0, o[2], 0, 0, 0); f2 = VFR(6);  SBAR(); \
            o[3] = __builtin_amdgcn_mfma_f32_32x32x16_bf16(f3, p0, o[3], 0, 0, 0); f3 = VFR(7);  SBAR(); \
            o[0] = __builtin_amdgcn_mfma_f32_32x32x16_bf16(f0, p1, o[0], 0, 0, 0); f0 = VFR(8);  SBAR(); \
            o[1] = __builtin_amdgcn_mfma_f32_32x32x16_bf16(f1, p1, o[1], 0, 0, 0); f1 = VFR(9);  SBAR(); \
            o[2] = __builtin_amdgcn_mfma_f32_32x32x16_bf16(f2, p1, o[2], 0, 0, 0); f2 = VFR(10);  SBAR(); \
            o[3] = __builtin_amdgcn_mfma_f32_32x32x16_bf16(f3, p1, o[3], 0, 0, 0); f3 = VFR(11);  SBAR(); \
            o[0] = __builtin_amdgcn_mfma_f32_32x32x16_bf16(f0, p2, o[0], 0, 0, 0); f0 = VFR(12);  SBAR(); \
            o[1] = __builtin_amdgcn_mfma_f32_32x32x16_bf16(f1, p2, o[1], 0, 0, 0); f1 = VFR(13);  SBAR(); \
            o[2] = __builtin_amdgcn_mfma_f32_32x32x16_bf16(f2, p2, o[2], 0, 0, 0); f2 = VFR(14);  SBAR(); \
            o[3] = __builtin_amdgcn_mfma_f32_32x32x16_bf16(f3, p2, o[3], 0, 0, 0); f3 = VFR(15);  SBAR(); \
            o[0] = __builtin_amdgcn_mfma_f32_32x32x16_bf16(f0, p3, o[0], 0, 0, 0); f0 = KFR(0);  SBAR(); \
            o[1] = __builtin_amdgcn_mfma_f32_32x32x16_bf16(f1, p3, o[1], 0, 0, 0); f1 = KFR(1);  SBAR(); \
            o[2] = __builtin_amdgcn_mfma_f32_32x32x16_bf16(f2, p3, o[2], 0, 0, 0); f2 = KFR(2);  SBAR(); \
            o[3] = __builtin_amdgcn_mfma_f32_32x32x16_bf16(f3, p3, o[3], 0, 0, 0); f3 = KFR(3);  SBAR(); \
            if (!(FAST_)) { float ma = max3f(C0[0], C0[1], C1[0]), mb = max3f(C0[2], C0[3], C1[1]); ma = max3f(ma, C1[2], C1[3]); \
            _Pragma("unroll") for (int r = 4; r < 16; r += 4) { ma = max3f(ma, C0[r], C0[r + 1]); mb = max3f(mb, C0[r + 2], C0[r + 3]); ma = max3f(ma, C1[r], C1[r + 1]); mb = max3f(mb, C1[r + 2], C1[r + 3]); } \
            const float mx = xhalf_max(max3f(ma, mb, mb)); \
            if (__any(mx > mrow)) { const float mn = max3f(mrow, mx, mx), al = __builtin_amdgcn_exp2f(mrow - mn); lrow *= al; mrow = mn; \
                _Pragma("unroll") for (int i = 0; i < 4; ++i) _Pragma("unroll") for (int r = 0; r < 16; ++r) o[i][r] *= al; } } \
            f32x4 ps = (f32x4){0.f, 0.f, 0.f, 0.f}; \
            N0 = f32x16{}; N1 = f32x16{}; \
            N0 = __builtin_amdgcn_mfma_f32_32x32x16_bf16(f0, qf[0], N0, 0, 0, 0); f0 = KFR(4); EXG(C0, 0, FAST_); SBAR(); \
            N1 = __builtin_amdgcn_mfma_f32_32x32x16_bf16(f1, qf[0], N1, 0, 0, 0); f1 = KFR(5); EXG(C0, 1, FAST_); SBAR(); \
            N0 = __builtin_amdgcn_mfma_f32_32x32x16_bf16(f2, qf[1], N0, 0, 0, 0); f2 = KFR(6); EXG(C0, 2, FAST_); p0 = PACK(C0, 0); SUM4(C0, 0); SUM4(C0, 1); SBAR(); \
            N1 = __builtin_amdgcn_mfma_f32_32x32x16_bf16(f3, qf[1], N1, 0, 0, 0); f3 = KFR(7); EXG(C0, 3, FAST_); SBAR(); \
            N0 = __builtin_amdgcn_mfma_f32_32x32x16_bf16(f0, qf[2], N0, 0, 0, 0); EXG(C1, 0, FAST_); p1 = PACK(C0, 1); SUM4(C0, 2); SUM4(C0, 3); SBAR(); \
            N1 = __builtin_amdgcn_mfma_f32_32x32x16_bf16(f1, qf[2], N1, 0, 0, 0); EXG(C1, 1, FAST_); SBAR(); \
            N0 = __builtin_amdgcn_mfma_f32_32x32x16_bf16(f2, qf[3], N0, 0, 0, 0); EXG(C1, 2, FAST_); p2 = PACK(C1, 0); SUM4(C1, 0); SUM4(C1, 1); SBAR(); \
            N1 = __builtin_amdgcn_mfma_f32_32x32x16_bf16(f3, qf[3], N1, 0, 0, 0); EXG(C1, 3, FAST_); SBAR(); \
            p3 = PACK(C1, 1); SUM4(C1, 2); SUM4(C1, 3); \
            lrow += (ps[0] + ps[1]) + (ps[2] + ps[3]); \
            if ((t_) + 3 < NT) asm volatile("s_waitcnt vmcnt(4) lgkmcnt(0)" ::: "memory"); else if ((t_) + 2 < NT) asm volatile("s_waitcnt vmcnt(2) lgkmcnt(0)" ::: "memory"); else asm volatile("s_waitcnt vmcnt(0) lgkmcnt(0)" ::: "memory"); \
            __builtin_amdgcn_s_barrier(); asm volatile("" ::: "memory"); \
            k0s = k0s == 2 ? 0 : k0s + 1; } while (0)
#define AT_STEP_B0(C0, C1, N0, N1, t_, FAST_) do { \
            if ((t_) + 3 < NT) AT_DMAK((t_) + 3, k0s); if ((t_) + 2 < NT) AT_DMAV((t_) + 2, ((t_) + 2) & 3); \
            const LAS unsigned char* bufK = lds + (k0s == 2 ? 0 : k0s + 1) * AT_KSLOT; int kadl = kad0, vadl = vad0; asm volatile("" : "+v"(kadl), "+v"(vadl)); \
            bf16x8 f0 = KFR(0), f1 = KFR(1), f2 = KFR(2), f3 = KFR(3); \
            if (!(FAST_)) { float ma = max3f(C0[0], C0[1], C1[0]), mb = max3f(C0[2], C0[3], C1[1]); ma = max3f(ma, C1[2], C1[3]); \
            _Pragma("unroll") for (int r = 4; r < 16; r += 4) { ma = max3f(ma, C0[r], C0[r + 1]); mb = max3f(mb, C0[r + 2], C0[r + 3]); ma = max3f(ma, C1[r], C1[r + 1]); mb = max3f(mb, C1[r + 2], C1[r + 3]); } \
            const float mx = xhalf_max(max3f(ma, mb, mb)); \
            if (__any(mx > mrow)) { const float mn = max3f(mrow, mx, mx), al = __builtin_amdgcn_exp2f(mrow - mn); lrow *= al; mrow = mn; \
                _Pragma("unroll") for (int i = 0; i < 4; ++i) _Pragma("unroll") for (int r = 0; r < 16; ++r) o[i][r] *= al; } } \
            f32x4 ps = (f32x4){0.f, 0.f, 0.f, 0.f}; \
            N0 = f32x16{}; N1 = f32x16{}; \
            N0 = __builtin_amdgcn_mfma_f32_32x32x16_bf16(f0, qf[0], N0, 0, 0, 0); f0 = KFR(4); EXG(C0, 0, FAST_); SBAR(); \
            N1 = __builtin_amdgcn_mfma_f32_32x32x16_bf16(f1, qf[0], N1, 0, 0, 0); f1 = KFR(5); EXG(C0, 1, FAST_); SBAR(); \
            N0 = __builtin_amdgcn_mfma_f32_32x32x16_bf16(f2, qf[1], N0, 0, 0, 0); f2 = KFR(6); EXG(C0, 2, FAST_); p0 = PACK(C0, 0); SUM4(C0, 0); SUM4(C0, 1); SBAR(); \
            N1 = __builtin_amdgcn_mfma_f32_32x32x16_bf16(f3, qf[1], N1, 0, 0, 0); f3 = KFR(7); EXG(C0, 3, FAST_); SBAR(); \
            N0 = __builtin_amdgcn_mfma_f32_32x32x16_bf16(f0, qf[2], N0, 0, 0, 0); EXG(C1, 0, FAST_); p1 = PACK(C0, 1); SUM4(C0, 2); SUM4(C0, 3); SBAR(); \
            N1 = __builtin_amdgcn_mfma_f32_32x32x16_bf16(f1, qf[2], N1, 0, 0, 0); EXG(C1, 1, FAST_); SBAR(); \
            N0 = __builtin_amdgcn_mfma_f32_32x32x16_bf16(f2, qf[3], N0, 0, 0, 0); EXG(C1, 2, FAST_); p2 = PACK(C1, 0); SUM4(C1, 0); SUM4(C1, 1); SBAR(); \
            N1 = __builtin_amdgcn_mfma_f32_32x32x16_bf16(f3, qf[3], N1, 0, 0, 0); EXG(C1, 3, FAST_); SBAR(); \
            p3 = PACK(C1, 1); SUM4(C1, 2); SUM4(C1, 3); \
            lrow += (ps[0] + ps[1]) + (ps[2] + ps[3]); \
            if ((t_) + 3 < NT) asm volatile("s_waitcnt vmcnt(4) lgkmcnt(0)" ::: "memory"); else if ((t_) + 2 < NT) asm volatile("s_waitcnt vmcnt(2) lgkmcnt(0)" ::: "memory"); else asm volatile("s_waitcnt vmcnt(0) lgkmcnt(0)" ::: "memory"); \
            __builtin_amdgcn_s_barrier(); asm volatile("" ::: "memory"); \
            k0s = k0s == 2 ? 0 : k0s + 1; } while (0)
#define AT_STEP_BF(t_) do { int vadl = vad0; \
            const LAS unsigned char* bufV = lds + AT_VBASE + (((t_) - 1) & 3) * AT_VSLOT; \
            bf16x8 f0 = VFR(0), f1 = VFR(1), f2 = VFR(2), f3 = VFR(3); \
            o[0] = __builtin_amdgcn_mfma_f32_32x32x16_bf16(f0, p0, o[0], 0, 0, 0); f0 = VFR(4);  SBAR(); \
            o[1] = __builtin_amdgcn_mfma_f32_32x32x16_bf16(f1, p0, o[1], 0, 0, 0); f1 = VFR(5);  SBAR(); \
            o[2] = __builtin_amdgcn_mfma_f32_32x32x16_bf16(f2, p0, o[2], 0, 0, 0); f2 = VFR(6);  SBAR(); \
            o[3] = __builtin_amdgcn_mfma_f32_32x32x16_bf16(f3, p0, o[3], 0, 0, 0); f3 = VFR(7);  SBAR(); \
            o[0] = __builtin_amdgcn_mfma_f32_32x32x16_bf16(f0, p1, o[0], 0, 0, 0); f0 = VFR(8);  SBAR(); \
            o[1] = __builtin_amdgcn_mfma_f32_32x32x16_bf16(f1, p1, o[1], 0, 0, 0); f1 = VFR(9);  SBAR(); \
            o[2] = __builtin_amdgcn_mfma_f32_32x32x16_bf16(f2, p1, o[2], 0, 0, 0); f2 = VFR(10);  SBAR(); \
            o[3] = __builtin_amdgcn_mfma_f32_32x32x16_bf16(f3, p1, o[3], 0, 0, 0); f3 = VFR(11);  SBAR(); \
            o[0] = __builtin_amdgcn_mfma_f32_32x32x16_bf16(f0, p2, o[0], 0, 0, 0); f0 = VFR(12);  SBAR(); \
            o[1] = __builtin_amdgcn_mfma_f32_32x32x16_bf16(f1, p2, o[1], 0, 0, 0); f1 = VFR(13);  SBAR(); \
            o[2] = __builtin_amdgcn_mfma_f32_32x32x16_bf16(f2, p2, o[2], 0, 0, 0); f2 = VFR(14);  SBAR(); \
            o[3] = __builtin_amdgcn_mfma_f32_32x32x16_bf16(f3, p2, o[3], 0, 0, 0); f3 = VFR(15);  SBAR(); \
            o[0] = __builtin_amdgcn_mfma_f32_32x32x16_bf16(f0, p3, o[0], 0, 0, 0);  SBAR(); \
            o[1] = __builtin_amdgcn_mfma_f32_32x32x16_bf16(f1, p3, o[1], 0, 0, 0);  SBAR(); \
            o[2] = __builtin_amdgcn_mfma_f32_32x32x16_bf16(f2, p3, o[2], 0, 0, 0);  SBAR(); \
            o[3] = __builtin_amdgcn_mfma_f32_32x32x16_bf16(f3, p3, o[3], 0, 0, 0);  SBAR(); \
            asm volatile("s_waitcnt vmcnt(0) lgkmcnt(0)" ::: "memory"); __builtin_amdgcn_s_barrier(); asm volatile("" ::: "memory"); } while (0)
    for (int u = vcu; u < 768; u += G) {
        const int bh = u >> 5, qc = u & 31, b = bh / 6, h = bh % 6;
        const int qrow = b * SEQ + qc * 128 + qi * 32 + r32;
        bf16x8 qf[4];
        { const bf16_t* qp = Q + (size_t)qrow * DQK + h * 128 + c * 64 + hi * 8;
#pragma unroll
          for (int d0 = 0; d0 < 4; ++d0) qf[d0] = *(const bf16x8*)(qp + d0 * 16); }
        AT_DMAK(0, 0); AT_DMAK(1, 1); AT_DMAV(0, 0); AT_DMAK(2, 2); AT_DMAV(1, 1);
        asm volatile("s_waitcnt vmcnt(8)" ::: "memory"); __builtin_amdgcn_s_barrier(); asm volatile("" ::: "memory");
        f32x16 o[4];
#pragma unroll
        for (int i = 0; i < 4; ++i) o[i] = f32x16{};
        float mrow = -1e30f, lrow = 0.f;
        f32x16 sa0 = f32x16{}, sa1 = f32x16{}, sb0, sb1;
#pragma unroll
        for (int d0 = 0; d0 < 4; ++d0) {
            const bf16x8 k0 = *(const LAS bf16x8*)(lds + (kad0 ^ (d0 * 32))), k1 = *(const LAS bf16x8*)(lds + (kad0 ^ (d0 * 32)) + 32 * 256);
            sa0 = __builtin_amdgcn_mfma_f32_32x32x16_bf16(k0, qf[d0], sa0, 0, 0, 0);
            sa1 = __builtin_amdgcn_mfma_f32_32x32x16_bf16(k1, qf[d0], sa1, 0, 0, 0); }
        asm volatile("s_waitcnt vmcnt(4) lgkmcnt(0)" ::: "memory"); __builtin_amdgcn_s_barrier(); asm volatile("" ::: "memory");
        int k0s = 0;
#define AT_MAIN(FAST_) do { \
        if (c == 0) { \
            for (int t = 0; t < NT; t += 2) { AT_STEP_A(sa0, sa1, sb0, sb1, t, FAST_); AT_STEP_A(sb0, sb1, sa0, sa1, t + 1, FAST_); } \
            asm volatile("s_waitcnt vmcnt(0) lgkmcnt(0)" ::: "memory"); __builtin_amdgcn_s_barrier(); asm volatile("" ::: "memory");     \
        } else { \
            bf16x8 p0, p1, p2, p3; \
            AT_STEP_B0(sa0, sa1, sb0, sb1, 0, FAST_); \
            for (int t = 1; t < NT - 1; t += 2) { AT_STEP_B(sb0, sb1, sa0, sa1, t, FAST_); AT_STEP_B(sa0, sa1, sb0, sb1, t + 1, FAST_); } \
            AT_STEP_B(sb0, sb1, sa0, sa1, NT - 1, FAST_); \
            AT_STEP_BF(NT); \
        } } while (0)
        if (c == 0) __builtin_amdgcn_s_setprio(3);
        if (fast) AT_MAIN(1); else AT_MAIN(0);
        __builtin_amdgcn_s_setprio(0);
#undef AT_MAIN
        lrow = xhalf_sum(lrow);
        const float inv = 1.0f / lrow;
        LAS float* scr = (LAS float*)lds + (size_t)qi * 4096;
        if (c == 1) {
            const float f = inv * lam;
#pragma unroll
            for (int i = 0; i < 4; ++i)
#pragma unroll
                for (int r = 0; r < 16; ++r) scr[(i * 16 + r) * 64 + lane] = o[i][r] * f;
        }
        __syncthreads();
        if (c == 0) {
            float ss = 0.f;
#pragma unroll
            for (int i = 0; i < 4; ++i)
#pragma unroll
                for (int r = 0; r < 16; ++r) { const float d = o[i][r] * inv - scr[(i * 16 + r) * 64 + lane]; o[i][r] = d; ss += d * d; }
            ss = xhalf_sum(ss);
            const float rn = (1.0f - LAMBDA_INIT) / sqrtf(ss * (1.0f / 128.0f) + RMS_EPS);
            int ln = lane; asm volatile("" : "+v"(ln));
            const int er32 = ln & 31, ehi = ln >> 5;
            LAS unsigned char* stg = lds + 65536 + qi * (32 * 272);
            const float* sg = A.in[I_SUBG] + 4 * ehi;
#pragma unroll
            for (int i = 0; i < 4; ++i)
#pragma unroll
                for (int rq = 0; rq < 4; ++rq) { const f32x4 gq = *(const f32x4*)(sg + 32 * i + 8 * rq);
                    u32x2 w; w.x = cvt_pk_bf16(o[i][4 * rq] * rn * gq[0], o[i][4 * rq + 1] * rn * gq[1]); w.y = cvt_pk_bf16(o[i][4 * rq + 2] * rn * gq[2], o[i][4 * rq + 3] * rn * gq[3]);
                    *(LAS u32x2*)(stg + er32 * 272 + (32 * i + 8 * rq + 4 * ehi) * 2) = w; }
            asm volatile("s_waitcnt lgkmcnt(0)" ::: "memory");
            bf16_t* obase = AO + (size_t)(qrow - r32) * DM + h * 128;
#pragma unroll
            for (int k = 0; k < 8; ++k) { const int row = 4 * k + (ln >> 4), ch = ln & 15;
                const u32x4 v = *(const LAS u32x4*)(stg + row * 272 + ch * 16);
                *(u32x4*)(obase + (size_t)row * DM + ch * 8) = v;
                if (k & 1) asm volatile("" ::: "memory"); }
        }
        __syncthreads();
    }
#undef AT_STEP_A
#undef AT_STEP_B
#undef AT_STEP_B0
#undef AT_STEP_BF
#undef SUM4
#undef PACK
#undef VFR
#undef KFR
#undef EXG
#undef SBAR
#undef AT_DMAK
#undef AT_DMAV
}

#define XB_TMO      128
#define XB_XCNT(j)  (256  + 64 * (j))
#define XB_XSUB(j)  (1280 + 64 * (j))
#define XB_XGEN(j)  (2304 + 64 * (j))
#define XB_TOP      3328
#define XB_TOPGEN   3392
#define XCD_BAR_WORDS 3456
#define XB_SPIN_CAP (1u << 18)

__device__ __forceinline__ unsigned xb_ld(unsigned* p)              { return __hip_atomic_load(p, __ATOMIC_RELAXED, __HIP_MEMORY_SCOPE_AGENT); }
__device__ __forceinline__ unsigned xb_add(unsigned* p, unsigned v) { return __hip_atomic_fetch_add(p, v, __ATOMIC_RELAXED, __HIP_MEMORY_SCOPE_AGENT); }
__device__ __forceinline__ unsigned xb_xcc_id() { return (unsigned)__builtin_amdgcn_s_getreg((3 << 11) | 20) & 0xFu; }
#define XB_SPIN(cond, bar) do { unsigned _sp = 0; while (cond) { __builtin_amdgcn_s_sleep(1); \
    if ((++_sp & 255u) == 0u) { if (xb_ld(&(bar)[XB_TMO])) break; if (_sp > XB_SPIN_CAP) { atomicAdd(&(bar)[XB_TMO], 1u); break; } } } } while (0)

struct XcdBarrier {
    unsigned* bar; unsigned x;
    volatile LAS unsigned* st;
};

__device__ __forceinline__ XcdBarrier xcd_barrier_post(unsigned* bar, volatile LAS unsigned* st) {
    XcdBarrier b; b.bar = bar; b.x = xb_xcc_id(); b.st = st;
    if (threadIdx.x == 0) (void)xb_add(&bar[XB_XCNT(b.x)], 1u);
    return b;
}
__device__ __forceinline__ void xcd_barrier_complete(unsigned* bar, unsigned x, unsigned& nloc, unsigned& nx) {
    const unsigned G = gridDim.x * gridDim.y * gridDim.z;
    unsigned sum, cnt, mine, sp = 0u;
    for (;;) {
        sum = 0u; cnt = 0u; mine = 0u;
#pragma unroll
        for (unsigned j = 0; j < 16; ++j) { const unsigned c = xb_ld(&bar[XB_XCNT(j)]); sum += c; cnt += (c > 0u) ? 1u : 0u; mine = (j == x) ? c : mine; }
        if (sum == G) break;
        __builtin_amdgcn_s_sleep(1);
        if ((++sp & 255u) == 0u) { if (xb_ld(&bar[XB_TMO])) break; if (sp > XB_SPIN_CAP) { atomicAdd(&bar[XB_TMO], 1u); break; } }
    }
    nloc = mine > 0u ? mine : 1u; nx = cnt > 0u ? cnt : 1u;
}

__device__ __forceinline__ void xcd_barrier(const XcdBarrier& b) {
    asm volatile("s_waitcnt vmcnt(0)" ::: "memory");
    __syncthreads();
    if (threadIdx.x == 0) {
        unsigned* bar = b.bar;
        __builtin_amdgcn_s_waitcnt(0);
        unsigned nloc = b.st[0], nx = b.st[1];
        if (nloc == 0u) { xcd_barrier_complete(bar, b.x, nloc, nx); b.st[0] = nloc; b.st[1] = nx; }
        const unsigned old = xb_add(&bar[XB_XSUB(b.x)], 1u);
        const unsigned gen = old / nloc;
        if (old + 1u == (gen + 1u) * nloc) {
            __builtin_amdgcn_fence(__ATOMIC_RELEASE, "agent");
            asm volatile("s_waitcnt vmcnt(0)" ::: "memory");
            const unsigned og = xb_add(&bar[XB_TOP], 1u);
            const unsigned tg = og / nx;
            if (og + 1u == (tg + 1u) * nx) xb_add(&bar[XB_TOPGEN], 1u);
            else XB_SPIN(xb_ld(&bar[XB_TOPGEN]) == tg, bar);
            __builtin_amdgcn_fence(__ATOMIC_ACQUIRE, "agent");
            xb_add(&bar[XB_XGEN(b.x)], 1u);
            asm volatile("s_waitcnt vmcnt(0)" ::: "memory");
        } else {
            XB_SPIN(xb_ld(&bar[XB_XGEN(b.x)]) == gen, bar);
            __builtin_amdgcn_fence(__ATOMIC_ACQUIRE, "agent");
            asm volatile("s_waitcnt vmcnt(0)" ::: "memory");
        }
    }
    __syncthreads();
}

__device__ __forceinline__ void wg_publish(unsigned* cnt) {
    asm volatile("s_waitcnt vmcnt(0)" ::: "memory"); __syncthreads();
    if (threadIdx.x == 0) __hip_atomic_fetch_add(cnt, 1u, __ATOMIC_RELAXED, __HIP_MEMORY_SCOPE_AGENT);
}
__device__ __forceinline__ void wg_await(unsigned* cnt, unsigned want) {
    if (threadIdx.x == 0) { unsigned sp = 0; while (__hip_atomic_load(cnt, __ATOMIC_RELAXED, __HIP_MEMORY_SCOPE_AGENT) < want) { __builtin_amdgcn_s_sleep(1); if (++sp > (1u << 24)) break; }
        __builtin_amdgcn_fence(__ATOMIC_ACQUIRE, "agent"); asm volatile("s_waitcnt vmcnt(0)" ::: "memory"); }
    __syncthreads();
}

__global__ void __launch_bounds__(512, 2) mk_fwd(Args A) {
    extern __shared__ __attribute__((aligned(16))) unsigned char lds_raw[];
    LAS unsigned char* lds = (LAS unsigned char*)lds_raw;
    const int tid = threadIdx.x, lane = tid & 63, wave = __builtin_amdgcn_readfirstlane(tid >> 6);
    const int G = gridDim.x, bx = blockIdx.x, vcu = (G % 8 == 0) ? (bx % 8) * (G / 8) + bx / 8 : bx;
    unsigned char* ws = A.ws;
    const float* mod = (const float*)(ws + WS_MOD);
    bf16_t* XN = (bf16_t*)(ws + WS_XN); bf16_t* Hb = (bf16_t*)(ws + WS_H);
    bf16_t* PARTB = (bf16_t*)(ws + WS_PART);
    const int lo = A.ph_lo, hi = A.ph_hi;
    const int NGW = G * 8;
#define IN(k) (lo <= (k) && (k) < hi)
    const bool fused = (G == 256) && (hi - lo == NPH);
    unsigned* pcnt = (unsigned*)(ws + WS_BAR) + 3584; float* xbuf = (float*)(ws + WS_XBUF);
    bf16_t* XB = (bf16_t*)(ws + WS_DFTM + 16 * MiB);
    unsigned* cctr = (unsigned*)(ws + WS_BAR) + 3840; unsigned* gcnt = (unsigned*)(ws + WS_BAR) + 3856;
#define PH_TID() int ptid = threadIdx.x; asm volatile("" : "+v"(ptid)); const int plane = ptid & 63; const int pwave = __builtin_amdgcn_readfirstlane(ptid >> 6); const int pgw = vcu * 8 + pwave; (void)plane; (void)pgw
    volatile LAS unsigned* bst = (volatile LAS unsigned*)(lds + 131072 + 64);
    if (tid < 2) bst[tid] = 0u;
    __syncthreads();
    XcdBarrier bar; bar.bar = (unsigned*)(ws + WS_BAR); bar.x = 0; bar.st = bst;
    if (hi - lo > 1) bar = xcd_barrier_post((unsigned*)(ws + WS_BAR), bst);
    if (lo < 0) cg::this_grid().sync();
#define SEAM(k) do { if (IN(k) && IN((k) + 1)) xcd_barrier(bar); } while (0)

    if (IN(0)) { PH_TID(); prologue(A, lds, vcu, G, ptid); }
    if (!fused) SEAM(0);
    if (IN(1)) { PH_TID();
        if (fused) wg_await(gcnt, 128u);
        int ma = pgw;
        for (; ma + NGW < MLAT; ma += 2 * NGW) { const int mb = ma + NGW; const float* pa = mod + (ma / SEQ) * MODLD; const float* pb = mod + (mb / SEQ) * MODLD;
            rownorm2<true>(A.in[I_X] + (size_t)ma * DM, A.in[I_X] + (size_t)mb * DM, A.in[I_N1G], pa, pa + DM, pb, pb + DM, XN + (size_t)ma * DM, XN + (size_t)mb * DM, nullptr, nullptr, plane); }
        if (ma < MLAT) { const float* pa = mod + (ma / SEQ) * MODLD; rownorm1<true>(A.in[I_X] + (size_t)ma * DM, nullptr, A.in[I_N1G], pa, pa + DM, XN + (size_t)ma * DM, nullptr, plane); }
        for (int r = pgw; r < MCTX; r += NGW)
            rownorm1<true>(A.in[I_CTX] + (size_t)r * DM, nullptr, A.in[I_N1G], mod + NB * MODLD + 0 * DM, mod + NB * MODLD + 1 * DM, XN + (size_t)(MLAT + r) * DM, nullptr, plane);
    }
    SEAM(1);
    if (IN(2)) { PH_TID();
        pg8::Order S{}; S.nseg = 1; S.G = G; S.c = bx; S.s0 = pg8::Seg{MALL / 256, 22, 0, (const char*)XN, (const char*)(ws + WS_WGU1), (size_t)256 * DM * 2, (size_t)256 * DM * 2}; S.total = (MALL / 256) * 22;
        pg8::EpiSwiGLU E{Hb};
        pg8::gemm_phase(lds, pg8::Gemm{DM, DM, DM}, S, E, ptid);
        { int ptid3 = threadIdx.x; asm volatile("" : "+v"(ptid3)); const int rem = S.total % G;
          if (rem == 0) weight_transposes(A, lds, vcu, G, ptid3, 1); else if (bx >= rem) weight_transposes(A, lds, bx - rem, G - rem, ptid3, 1); }
    }
    SEAM(2);
    if (IN(3)) { PH_TID();
        pg8::Order S2{}; S2.nseg = 1; S2.G = G; S2.c = bx; S2.s0 = pg8::Seg{MCTX / 256, 4, 0, (const char*)(Hb + (size_t)MLAT * DFF), (const char*)(ws + WS_WD1), (size_t)256 * DFF * 2, (size_t)256 * DFF * 2, 11, 512, 512}; S2.total = 4 * 4 * 11;
        pg8::EpiCtxPart E2{PARTB, mod + 2 * DM, 0.5f};
        pg8::gemm_phase(lds, pg8::Gemm{256, DFF, DFF}, S2, E2, ptid);
        if (fused) wg_publish(cctr);
        pg8::Order S{}; S.nseg = 1; S.G = G; S.c = bx; S.s0 = pg8::Seg{MLAT / 256, 4, 0, (const char*)Hb, (const char*)(ws + WS_WD1), (size_t)256 * DFF * 2, (size_t)256 * DFF * 2, 1, 0, 0}; S.total = (MLAT / 256) * 4;
        if (fused) { pg8::EpiResidNorm<0, false> E{A.in[I_X], A.out, mod + 2 * DM, 0.5f, A.in[I_NMG], mod + 3 * DM, mod + 4 * DM, XN, xbuf, pcnt, XB};
            pg8::gemm_phase(lds, pg8::Gemm{DFF, DFF, DFF}, S, E, ptid);
            wg_await(cctr, (unsigned)G);
            if (pwave < 4) { const int r = vcu * 4 + pwave;
                rownorm1<true>(A.in[I_CTX] + (size_t)r * DM, PARTB + (size_t)r * DM, A.in[I_NMG], mod + NB * MODLD + 3 * DM, mod + NB * MODLD + 4 * DM, XN + (size_t)(MLAT + r) * DM, nullptr, plane); } }
        else { pg8::EpiResid E{A.in[I_X], A.out, nullptr, nullptr, mod + 2 * DM, 0.5f};
            pg8::gemm_phase(lds, pg8::Gemm{DFF, DFF, DFF}, S, E, ptid); }
    }
    if (!fused) SEAM(3);
    if (IN(4) && !fused) { PH_TID();
        int ma = pgw;
        for (; ma + NGW < MLAT; ma += 2 * NGW) { const int mb = ma + NGW; const float* pa = mod + (ma / SEQ) * MODLD + 3 * DM; const float* pb = mod + (mb / SEQ) * MODLD + 3 * DM;
            rownorm2<true>(A.out + (size_t)ma * DM, A.out + (size_t)mb * DM, A.in[I_NMG], pa, pa + DM, pb, pb + DM, XN + (size_t)ma * DM, XN + (size_t)mb * DM, nullptr, nullptr, plane); }
        if (ma < MLAT) { const float* pa = mod + (ma / SEQ) * MODLD + 3 * DM; rownorm1<true>(A.out + (size_t)ma * DM, nullptr, A.in[I_NMG], pa, pa + DM, XN + (size_t)ma * DM, nullptr, plane); }
        for (int r = pgw; r < MCTX; r += NGW)
            rownorm1<true>(A.in[I_CTX] + (size_t)r * DM, PARTB + (size_t)r * DM, A.in[I_NMG], mod + NB * MODLD + 3 * DM, mod + NB * MODLD + 4 * DM, XN + (size_t)(MLAT + r) * DM, nullptr, plane);
    }
    SEAM(4);
    if (IN(5)) { PH_TID();
        const char* WIN = (const char*)(ws + WS_WIN); const size_t T = (size_t)256 * DM * 2;
        pg8::Order S{}; S.nseg = 4; S.G = G; S.c = bx;
        S.s0 = pg8::Seg{MLAT / 256, 3, 0, (const char*)XN, WIN, T, T};
        S.s1 = pg8::Seg{MALL / 256, 3, 1, (const char*)XN, WIN + 3 * T, T, T};
        S.s2 = pg8::Seg{3, MALL / 256, 2, WIN + 6 * T, (const char*)XN, T, T};
        S.s3 = pg8::Seg{2, MLAT / 256, 3, (const char*)(ws + WS_WF), (const char*)XN, T, T};
        S.total = 64 * 3 + 68 * 3 + 3 * 68 + 2 * 64;
        pg8::EpiInProj E{(bf16_t*)(ws + WS_Q), (bf16_t*)(ws + WS_K), (bf16_t*)(ws + WS_VT), (bf16_t*)(ws + WS_DFTB), (const float*)(ws + WS_ROPE), (const float*)(ws + WS_ROPE) + 1024, (unsigned*)(ws + WS_BAR) + 3456};
        pg8::gemm_phase<pg8::EpiInProj, true>(lds, pg8::Gemm{DM, DM, DM}, S, E, ptid);
        { int ptid3 = threadIdx.x; asm volatile("" : "+v"(ptid3)); const int rem = S.total % G;
          if (rem == 0) { weight_transposes(A, lds, vcu, G, ptid3, 2); weight_transposes(A, lds, vcu, G, ptid3, 4); }
          else if (bx >= rem) { weight_transposes(A, lds, bx - rem, G - rem, ptid3, 2); weight_transposes(A, lds, bx - rem, G - rem, ptid3, 4); } }
    }
    SEAM(5);
    if (IN(6)) { PH_TID();
        unsigned* fcnt = (unsigned*)(ws + WS_BAR) + 3968;
        { pg8::Order S{}; S.nseg = 1; S.G = G; S.c = bx; S.s0 = pg8::Seg{1, 256, 0, (const char*)(ws + WS_M1), (const char*)(ws + WS_DFTB), 0, (size_t)256 * 128 * 2}; S.total = 256;
          pg8::EpiFFT1 E{(bf16_t*)(ws + WS_YT), (const f32x2*)(ws + WS_TW)};
          pg8::gemm_phase(lds, pg8::Gemm{128, 128, 128}, S, E, ptid); }
        wg_publish(fcnt);
        { int ptid1 = threadIdx.x; asm volatile("" : "+v"(ptid1)); attn_phase(A, lds, vcu, G, ptid1); }
        if (threadIdx.x == 0) { unsigned sp = 0; while (__hip_atomic_load(fcnt, __ATOMIC_RELAXED, __HIP_MEMORY_SCOPE_AGENT) < (unsigned)G) { __builtin_amdgcn_s_sleep(2); if (++sp > (1u << 24)) break; }
            __builtin_amdgcn_fence(__ATOMIC_ACQUIRE, "agent"); asm volatile("s_waitcnt vmcnt(0)" ::: "memory"); }
        __syncthreads();
        { int ptid2 = threadIdx.x; asm volatile("" : "+v"(ptid2));
          pg8::Order S{}; S.nseg = 1; S.G = G; S.c = bx; S.s0 = pg8::Seg{1, 256, 0, (const char*)(ws + WS_M2), (const char*)(ws + WS_YT), 0, (size_t)256 * 128 * 2}; S.total = 256;
          pg8::EpiFFT2 E{(bf16_t*)(ws + WS_AO)};
          pg8::gemm_phase(lds, pg8::Gemm{128, 128, 128}, S, E, ptid2); }
    }
    SEAM(6);
    if (IN(7)) { PH_TID();
        pg8::Order S{}; S.nseg = 1; S.G = G; S.c = bx; S.s0 = pg8::Seg{MLAT / 256, 4, 0, (const char*)(ws + WS_AO), (const char*)(ws + WS_WO), (size_t)256 * DM * 2, (size_t)256 * DM * 2}; S.total = 256;
        if (fused) { pg8::EpiResidNorm<0, true> E{A.out, A.out, mod + 5 * DM, 1.0f, A.in[I_N2G], mod + 6 * DM, mod + 7 * DM, XN, xbuf + 65536, pcnt + 64, XB};
            pg8::gemm_phase(lds, pg8::Gemm{DM, DM, DM}, S, E, ptid); }
        else { pg8::EpiResid E{A.out, A.out, nullptr, nullptr, mod + 5 * DM, 1.0f};
            pg8::gemm_phase(lds, pg8::Gemm{DM, DM, DM}, S, E, ptid); }
    }
    if (!fused) SEAM(7);
    if (IN(8) && !fused) { PH_TID();
        int ma = pgw;
        for (; ma + NGW < MLAT; ma += 2 * NGW) { const int mb = ma + NGW; const float* pa = mod + (ma / SEQ) * MODLD + 6 * DM; const float* pb = mod + (mb / SEQ) * MODLD + 6 * DM;
            rownorm2<true>(A.out + (size_t)ma * DM, A.out + (size_t)mb * DM, A.in[I_N2G], pa, pa + DM, pb, pb + DM, XN + (size_t)ma * DM, XN + (size_t)mb * DM, nullptr, nullptr, plane); }
        if (ma < MLAT) { const float* pa = mod + (ma / SEQ) * MODLD + 6 * DM; rownorm1<true>(A.out + (size_t)ma * DM, nullptr, A.in[I_N2G], pa, pa + DM, XN + (size_t)ma * DM, nullptr, plane); }
    }
    SEAM(8);
    if (IN(9)) { PH_TID();
        pg8::Order S{}; S.nseg = 1; S.G = G; S.c = bx; S.s0 = pg8::Seg{MLAT / 256, 22, 0, (const char*)XN, (const char*)(ws + WS_WGU2), (size_t)256 * DM * 2, (size_t)256 * DM * 2}; S.total = 64 * 22;
        pg8::EpiSwiGLU E{Hb};
        pg8::gemm_phase(lds, pg8::Gemm{DM, DM, DM}, S, E, ptid);
        { int ptid3 = threadIdx.x; asm volatile("" : "+v"(ptid3)); const int rem = S.total % G;
          if (rem == 0) weight_transposes(A, lds, vcu, G, ptid3, 3); else if (bx >= rem) weight_transposes(A, lds, bx - rem, G - rem, ptid3, 3); }
    }
    SEAM(9);
    if (IN(10)) { PH_TID();
        pg8::Order S{}; S.nseg = 1; S.G = G; S.c = bx; S.s0 = pg8::Seg{MLAT / 256, 4, 0, (const char*)Hb, (const char*)(ws + WS_WD2), (size_t)256 * DFF * 2, (size_t)256 * DFF * 2}; S.total = 256;
        if (fused) { pg8::EpiResidNorm<1, true> E{A.out, A.out, mod + 8 * DM, 0.5f, A.in[I_FNG], nullptr, nullptr, nullptr, xbuf + 131072, pcnt + 128, XB};
            pg8::gemm_phase(lds, pg8::Gemm{DFF, DFF, DFF}, S, E, ptid); }
        else { pg8::EpiResid E{A.out, A.out, nullptr, nullptr, mod + 8 * DM, 0.5f};
            pg8::gemm_phase(lds, pg8::Gemm{DFF, DFF, DFF}, S, E, ptid); }
    }
    if (!fused) SEAM(10);
    if (IN(11) && !fused) { PH_TID();
        int ma = pgw;
        for (; ma + NGW < MLAT; ma += 2 * NGW) { const int mb = ma + NGW;
            rownorm2<false>(A.out + (size_t)ma * DM, A.out + (size_t)mb * DM, A.in[I_FNG], nullptr, nullptr, nullptr, nullptr, nullptr, nullptr, A.out + (size_t)ma * DM, A.out + (size_t)mb * DM, plane); }
        if (ma < MLAT) rownorm1<false>(A.out + (size_t)ma * DM, nullptr, A.in[I_FNG], nullptr, nullptr, nullptr, A.out + (size_t)ma * DM, plane);
    }
#undef IN
#undef SEAM
}

extern "C" void kernel_launch(void* const* d_in, const int* in_sizes, int n_in, void* d_out, int out_size, void* d_ws, size_t ws_size, hipStream_t stream) {
    static int grid = 0;
    if (grid == 0) {
        if (n_in != 24 || out_size != MLAT * DM || ws_size < WS_END) { fprintf(stderr, "kernel_launch: unexpected shapes (n_in %d out %d ws %zu)\n", n_in, out_size, ws_size); grid = -1; return; }
        int dev = 0, cus = 0, per_cu = 0;
        hipGetDevice(&dev); hipDeviceGetAttribute(&cus, hipDeviceAttributeMultiprocessorCount, dev);
        hipFuncSetAttribute((const void*)mk_fwd, hipFuncAttributeMaxDynamicSharedMemorySize, LDS_BYTES);
        hipOccupancyMaxActiveBlocksPerMultiprocessor(&per_cu, (const void*)mk_fwd, 512, LDS_BYTES);
        if (per_cu < 1) { fprintf(stderr, "kernel_launch: occupancy query says %d blocks per CU\n", per_cu); per_cu = 1; }
        (void)hipGetLastError();
        grid = cus;
        if (grid % 8) grid -= grid % 8;
    }
    if (grid < 0) return;
    Args a{};
    for (int i = 0; i < 24; ++i) a.in[i] = (const float*)d_in[i];
    a.out = (float*)d_out; a.ws = (unsigned char*)d_ws;
#if MK_N_LAUNCHES == 1
    (void)hipMemsetAsync((char*)d_ws + WS_BAR, 0, BAR_BYTES, stream);
    a.ph_lo = 0; a.ph_hi = NPH;
    void* args[] = {&a};
    hipError_t e = hipLaunchCooperativeKernel((const void*)mk_fwd, dim3(grid), dim3(512), args, LDS_BYTES, stream);
    if (e != hipSuccess) fprintf(stderr, "cooperative launch failed: %s (grid %d)\n", hipGetErrorString(e), grid);
#else
    for (int p = 0; p < NPH; ++p) { a.ph_lo = p; a.ph_hi = p + 1; hipLaunchKernelGGL(mk_fwd, dim3(grid), dim3(512), LDS_BYTES, stream, a); }
#endif
}
```
